# Optimizing an MI355X kernel written in HIP

```python
import jax, jax.numpy as jnp
from jax import lax
import numpy as np

D_MODEL = 1024
BATCH = 4
SEQ = 4096
DEPTH = 1

MIX_WIDTH = D_MODEL
HGRN_WIDTH = MIX_WIDTH // 2
HGRN_HEADS = 4
HGRN_HEAD_DIM = HGRN_WIDTH // HGRN_HEADS
HGRN_CHUNK = 64
GMLP_WIDTH = MIX_WIDTH - HGRN_WIDTH
GMLP_GROUPS = 4
GMLP_GROUP_DIM = GMLP_WIDTH // GMLP_GROUPS
GMLP_CHUNK = 128
IN_PROJ_WIDTH = 4 * HGRN_WIDTH + 2 * GMLP_WIDTH
N_EXPERTS = 32
TOP_K = 4
D_FF = D_MODEL
SWIGLU_LIMIT = 7.0
SWIGLU_ALPHA = 1.702
MOE_BLOCK = 256
EPS = 1e-6

kernel_name = "hybrid_hgrn2_gmlp_moe_adaln"


def rms_norm(x, g):
    xf = x.astype(jnp.float32)
    y = xf * lax.rsqrt(jnp.mean(xf * xf, axis=-1, keepdims=True) + EPS)
    return (y * g.astype(jnp.float32)).astype(x.dtype)


def layer_norm(x, g, b):
    xf = x.astype(jnp.float32)
    mu = jnp.mean(xf, axis=-1, keepdims=True)
    var = jnp.mean(jnp.square(xf - mu), axis=-1, keepdims=True)
    y = (xf - mu) * lax.rsqrt(var + EPS)
    return (y * g.astype(jnp.float32) + b.astype(jnp.float32)).astype(x.dtype)


def hgrn2_chunk_scan(q, k, v, logf):
    B, S, H, DK = q.shape
    DV = v.shape[-1]
    nc = S // HGRN_CHUNK

    def to_chunks(t):
        return t.reshape(B, nc, HGRN_CHUNK, H, t.shape[-1]).transpose(1, 0, 3, 2, 4)

    causal = jnp.tril(jnp.ones((HGRN_CHUNK, HGRN_CHUNK), dtype=bool))[:, :, None]

    def step(state, inp):
        qc, kc, vc, gc = inp
        b = jnp.cumsum(gc, axis=2)
        o_inter = jnp.einsum('bhtk,bhkv->bhtv', qc * jnp.exp(b), state)
        diff = b[:, :, :, None, :] - b[:, :, None, :, :]
        decay = jnp.exp(jnp.where(causal, diff, -jnp.inf))
        scores = jnp.einsum('bhtk,bhsk,bhtsk->bhts', qc, kc, decay)
        o_intra = jnp.einsum('bhts,bhsv->bhtv', scores, vc)
        b_last = b[:, :, -1:, :]
        k_dec = kc * jnp.exp(b_last - b)
        new_state = jnp.exp(b_last[:, :, 0, :])[..., None] * state + jnp.einsum('bhsk,bhsv->bhkv', k_dec, vc)
        return new_state, o_inter + o_intra

    state0 = jnp.zeros((B, H, DK, DV), jnp.float32)
    _, o = lax.scan(step, state0, (to_chunks(q), to_chunks(k), to_chunks(v), to_chunks(logf)))
    return o.transpose(1, 0, 3, 2, 4).reshape(B, S, H, DV)


def hgrn2_mixer(zq, zf, zi, zg, lb, norm_g):
    B, S, _ = zq.shape
    shp = (B, S, HGRN_HEADS, HGRN_HEAD_DIM)
    lb = lb.astype(jnp.float32)
    f = lb + (1.0 - lb) * jax.nn.sigmoid(zf.astype(jnp.float32))
    logf = jnp.log(f).reshape(shp)
    k = (1.0 - f).reshape(shp)
    q = zq.astype(jnp.float32).reshape(shp)
    v = zi.astype(jnp.float32).reshape(shp)
    o = hgrn2_chunk_scan(q, k, v, logf).astype(zq.dtype)
    o = rms_norm(o, norm_g.reshape(HGRN_HEADS, HGRN_HEAD_DIM))
    o = o * jax.nn.silu(zg).reshape(shp)
    return o.reshape(B, S, HGRN_WIDTH)


def gmlp_mixer(zu, zv, ln_g, ln_b, ws, bs, norm_g):
    B, S, _ = zu.shape
    nc = S // GMLP_CHUNK
    shp = (B, nc, GMLP_CHUNK, GMLP_GROUPS, GMLP_GROUP_DIM)
    u = jax.nn.gelu(zu, approximate=False)
    v = layer_norm(jax.nn.gelu(zv, approximate=False), ln_g, ln_b).reshape(shp)
    ws_causal = ws * jnp.tril(jnp.ones((GMLP_CHUNK, GMLP_CHUNK), ws.dtype))
    sv = jnp.einsum('gts,bnsgd->bntgd', ws_causal, v) + bs.T[None, None, :, :, None]
    y = u.reshape(shp) * sv
    y = rms_norm(y, norm_g.reshape(GMLP_GROUPS, GMLP_GROUP_DIM))
    return y.reshape(B, S, GMLP_WIDTH)


def moe_ffn(h, router_w, router_b, w_gate_up, b_gate_up, w_down, b_down):
    N, D = h.shape
    logits = h.astype(jnp.float32) @ router_w.astype(jnp.float32) + router_b.astype(jnp.float32)
    top_val, top_idx = lax.top_k(logits, TOP_K)
    gates = jax.nn.softmax(top_val, axis=-1)

    NK = N * TOP_K
    flat_e = top_idx.reshape(-1)
    flat_g = gates.reshape(-1)
    order = jnp.argsort(flat_e)
    sorted_e = flat_e[order]
    tok = (order // TOP_K).astype(jnp.int32)
    counts = jnp.bincount(flat_e, length=N_EXPERTS)
    padded = ((counts + MOE_BLOCK - 1) // MOE_BLOCK) * MOE_BLOCK
    start_sorted = jnp.cumsum(counts) - counts
    pad_end = jnp.cumsum(padded)
    start_pad = pad_end - padded
    dest = start_pad[sorted_e] + (jnp.arange(NK) - start_sorted[sorted_e])

    P = ((NK + N_EXPERTS * (MOE_BLOCK - 1) + MOE_BLOCK - 1) // MOE_BLOCK) * MOE_BLOCK
    n_blocks = P // MOE_BLOCK
    row_tok = jnp.full((P,), N, jnp.int32).at[dest].set(tok)
    row_gate = jnp.zeros((P,), jnp.float32).at[dest].set(flat_g[order])
    block_start = jnp.arange(n_blocks) * MOE_BLOCK
    block_expert = jnp.minimum(jnp.searchsorted(pad_end, block_start, side='right'), N_EXPERTS - 1)

    h_pad = jnp.concatenate([h, jnp.zeros((1, D), h.dtype)], axis=0)
    xb = h_pad[row_tok].reshape(n_blocks, MOE_BLOCK, D)

    def expert_block(args):
        xblk, e = args
        gu = xblk @ w_gate_up[e] + b_gate_up[e]
        gate, up = gu[:, :D_FF], gu[:, D_FF:]
        gate = jnp.minimum(gate, SWIGLU_LIMIT)
        up = jnp.clip(up, -SWIGLU_LIMIT, SWIGLU_LIMIT)
        glu = gate * jax.nn.sigmoid(SWIGLU_ALPHA * gate)
        return ((up + 1.0) * glu) @ w_down[e] + b_down[e]

    yb = lax.map(expert_block, (xb, block_expert)).reshape(P, D)
    yb = yb * row_gate.astype(yb.dtype)[:, None]
    out = jnp.zeros((N + 1, D), yb.dtype).at[row_tok].add(yb)
    return out[:N]


def setup_inputs(seed: int = 0) -> dict:
    key = jax.random.key(seed)
    ks = jax.random.split(key, 24)
    f32 = jnp.float32
    L = DEPTH
    nrm = lambda k, shape, s: (jax.random.normal(k, shape, f32) * s)
    return {
        "x": nrm(ks[0], (BATCH, SEQ, D_MODEL), 1.0),
        "c": nrm(ks[1], (BATCH, D_MODEL), 1.0),
        "ada_w": nrm(ks[2], (L, D_MODEL, 6 * D_MODEL), 0.5 * D_MODEL ** -0.5),
        "ada_b": nrm(ks[3], (L, 6 * D_MODEL), 0.02),
        "norm_mix_g": 1.0 + nrm(ks[4], (L, D_MODEL), 0.05),
        "w_in": nrm(ks[5], (L, D_MODEL, IN_PROJ_WIDTH), D_MODEL ** -0.5),
        "lb_params": nrm(ks[6], (L + 1, HGRN_WIDTH), 1.0),
        "hgrn_norm_g": 1.0 + nrm(ks[7], (L, HGRN_WIDTH), 0.05),
        "gmlp_ln_g": 1.0 + nrm(ks[8], (L, GMLP_WIDTH), 0.05),
        "gmlp_ln_b": nrm(ks[9], (L, GMLP_WIDTH), 0.02),
        "gmlp_ws": nrm(ks[10], (L, GMLP_GROUPS, GMLP_CHUNK, GMLP_CHUNK), GMLP_CHUNK ** -0.5),
        "gmlp_bs": 1.0 + nrm(ks[11], (L, GMLP_GROUPS, GMLP_CHUNK), 0.1),
        "gmlp_norm_g": 1.0 + nrm(ks[12], (L, GMLP_WIDTH), 0.05),
        "w_out": nrm(ks[13], (L, MIX_WIDTH, D_MODEL), MIX_WIDTH ** -0.5),
        "norm_ffn_g": 1.0 + nrm(ks[14], (L, D_MODEL), 0.05),
        "router_w": nrm(ks[15], (L, D_MODEL, N_EXPERTS), D_MODEL ** -0.5),
        "router_b": nrm(ks[16], (L, N_EXPERTS), 0.01),
        "w_gate_up": nrm(ks[17], (L, N_EXPERTS, D_MODEL, 2 * D_FF), D_MODEL ** -0.5),
        "b_gate_up": nrm(ks[18], (L, N_EXPERTS, 2 * D_FF), 0.02),
        "w_down": nrm(ks[19], (L, N_EXPERTS, D_FF, D_MODEL), D_FF ** -0.5),
        "b_down": nrm(ks[20], (L, N_EXPERTS, D_MODEL), 0.02),
        "final_g": 1.0 + nrm(ks[21], (D_MODEL,), 0.05),
    }


def reference(x, c, ada_w, ada_b, norm_mix_g, w_in, lb_params, hgrn_norm_g, gmlp_ln_g, gmlp_ln_b,
              gmlp_ws, gmlp_bs, gmlp_norm_g, w_out, norm_ffn_g, router_w, router_b, w_gate_up,
              b_gate_up, w_down, b_down, final_g):
    B, S, D = x.shape
    lb_all = jnp.cumsum(jax.nn.softmax(lb_params.astype(jnp.float32), axis=0), axis=0)
    c_act = jax.nn.silu(c)
    splits = [HGRN_WIDTH, 2 * HGRN_WIDTH, 3 * HGRN_WIDTH, 4 * HGRN_WIDTH, 4 * HGRN_WIDTH + GMLP_WIDTH]
    for l in range(DEPTH):
        mod = (c_act @ ada_w[l] + ada_b[l])[:, None, :]
        shift1, scale1, gate1, shift2, scale2, gate2 = jnp.split(mod, 6, axis=-1)

        h = rms_norm(x, norm_mix_g[l]) * (1.0 + scale1) + shift1
        z = h @ w_in[l]
        zq, zf, zi, zg, zu, zv = jnp.split(z, splits, axis=-1)
        y_hgrn = hgrn2_mixer(zq, zf, zi, zg, lb_all[l], hgrn_norm_g[l])
        y_gmlp = gmlp_mixer(zu, zv, gmlp_ln_g[l], gmlp_ln_b[l], gmlp_ws[l], gmlp_bs[l], gmlp_norm_g[l])
        y = jnp.concatenate([y_hgrn, y_gmlp], axis=-1) @ w_out[l]
        x = x + gate1 * y

        h = rms_norm(x, norm_ffn_g[l]) * (1.0 + scale2) + shift2
        y = moe_ffn(h.reshape(B * S, D), router_w[l], router_b[l], w_gate_up[l], b_gate_up[l],
                    w_down[l], b_down[l]).reshape(B, S, D)
        x = x + gate2 * y
    return rms_norm(x, final_g)
```

```cpp
#include <hip/hip_runtime.h>
#include <cstdio>
#include <cstdint>

#define GAS __attribute__((address_space(1)))
#define LAS __attribute__((address_space(3)))
typedef unsigned short bf16;
typedef unsigned u32x4 __attribute__((ext_vector_type(4)));
typedef unsigned u32x2 __attribute__((ext_vector_type(2)));
typedef float f32x4 __attribute__((ext_vector_type(4)));
typedef float f32x2 __attribute__((ext_vector_type(2)));
typedef short bf16x8 __attribute__((ext_vector_type(8)));
typedef __bf16 bf16x2_t __attribute__((ext_vector_type(2)));

constexpr int DM = 1024, NB = 4, SEQ = 4096, MT = NB * SEQ;
constexpr int HW = 512, NH = 4, HD = 128, HCH = 64;
constexpr int GW = 512, GG = 4, GD = 128, GCH = 128;
constexpr int NIN = 3072, NE = 32, TOPK = 4, DFF = 1024;
constexpr int NSLOT = MT * TOPK;
constexpr int LSTRIDE = MT;
constexpr float EPS = 1e-6f;
constexpr float SW_LIMIT = 7.0f, SW_ALPHA = 1.702f;

constexpr size_t MiB = 1u << 20;
constexpr size_t WS_CTL = 0, CTL_ZERO_BYTES = 64 * 1024;
constexpr size_t WS_MOD = 1 * MiB;
constexpr size_t WS_LB = 1 * MiB + 128 * 1024;
constexpr size_t WS_WIN = 2 * MiB;
constexpr size_t WS_WOUT = 8 * MiB;
constexpr size_t WS_WGU = 16 * MiB;
constexpr size_t WS_WD = 144 * MiB;
constexpr size_t WS_H = 208 * MiB;
constexpr size_t WS_Z = 240 * MiB;
constexpr size_t WS_YMIX = 336 * MiB;
constexpr size_t WS_XMID = 368 * MiB;
constexpr size_t WS_KV = 432 * MiB;
constexpr size_t WS_DEC = 496 * MiB;
constexpr size_t WS_GATES = 497 * MiB;
constexpr size_t WS_LISTS = 498 * MiB;
constexpr size_t WS_ACT = 512 * MiB;
constexpr size_t WS_YSLOT = 656 * MiB;
constexpr size_t WS_OH = 784 * MiB;
constexpr size_t WS_VLN = 816 * MiB;
constexpr size_t WS_YG = 848 * MiB;
constexpr size_t WS_END = 880 * MiB;
constexpr int CW_TMO = 0, CW_CODE = 1;
constexpr int CW_BAR = 1024;
constexpr int CW_CNT = 8192;
static_assert((CW_CNT + 64 * 32) * 4 <= (int)CTL_ZERO_BYTES, "ctl");

constexpr int LDS_BYTES = 163840;
constexpr int LDSCTL_OFF = 162816;
constexpr int MISC_BAR = 8;
constexpr int MOE_TAB = 64;

__device__ __forceinline__ float bf2f(unsigned short b) { return __uint_as_float(((unsigned)b) << 16); }
__device__ __forceinline__ unsigned pk2(float lo, float hi) { f32x2 v = {lo, hi}; bf16x2_t b = __builtin_convertvector(v, bf16x2_t); return __builtin_bit_cast(unsigned, b); }
__device__ __forceinline__ float bflo(unsigned w) { return __uint_as_float(w << 16); }
__device__ __forceinline__ float bfhi(unsigned w) { return __uint_as_float(w & 0xffff0000u); }
__device__ __forceinline__ float wave_sum(float v) {
#pragma unroll
    for (int o = 1; o < 64; o <<= 1) v += __shfl_xor(v, o);
    return v;
}
__device__ __forceinline__ float fsigmoid(float z) { return __frcp_rn(1.0f + __expf(-z)); }
__device__ __forceinline__ f32x2 gelu_pk(f32x2 v) {
    const f32x2 av = __builtin_elementwise_abs(v), d = av * 0.2316418882f + 1.0f;
    f32x2 t; t.x = __builtin_amdgcn_rcpf(d.x); t.y = __builtin_amdgcn_rcpf(d.y);
    f32x2 q = t * 0.5307027145f + (-0.7265760135f); q = q * t + 0.7107068705f; q = q * t + (-0.142248368f); q = q * t + 0.127414796f; q = q * t;
    const f32x2 s = (v * v) * (-0.72134752044f);
    f32x2 e; e.x = __builtin_amdgcn_exp2f(s.x); e.y = __builtin_amdgcn_exp2f(s.y);
    const f32x2 m = v * (q * e), r = v - m;
    f32x2 o; o.x = v.x < 0.f ? m.x : r.x; o.y = v.y < 0.f ? m.y : r.y; return o;
}
__device__ __forceinline__ float gelu1(float x) { f32x2 r = gelu_pk((f32x2){x, x}); return r.x; }

namespace pg8 {
constexpr int BM = 256, BK = 64, HALF = 128, HTB = HALF * BK * 2, STAGE_BYTES = 8 * HTB, NXCD = 8, WGM = 8;
__host__ __device__ __forceinline__ int lds_byte(int r, int c) { const int st = (r >> 4) * 2 + (c >> 5), rr = r & 15, cc = c & 31, ob = rr * 64 + cc * 2; return st * 1024 + (ob ^ (((ob >> 9) & 1) << 5)); }
__host__ __device__ __forceinline__ void stage_rc(int b, int& R, int& C) { const int st = b / 1024, sb = b % 1024, swz = sb ^ (((sb >> 9) & 1) << 5); R = (st >> 1) * 16 + swz / 64; C = (st & 1) * 32 + (swz % 64) / 2; }
__host__ __device__ __forceinline__ int perm32(int rho) { const int n = rho >> 4, i = rho & 15; return 8 * (i >> 2) + 4 * n + (i & 3); }

struct Unit { int pm, pn, e, rb, cnt; };

struct DenseSched {
    static constexpr bool GATHER = false;
    const bf16* A; const bf16* Bt; int K;
    int nM, nN, nwg, G, c;
    __device__ void init(const bf16* A_, const bf16* Bt_, int M, int N, int K_, int G_, int c_) { A = A_; Bt = Bt_; K = K_; nM = M / BM; nN = N / BM; nwg = nM * nN; G = G_; c = c_; }
    __device__ __forceinline__ bool next(int i, Unit& u) const {
        const long L = (long)i * G + c; if (L >= nwg) return false;
        int wgid = (int)L; { const int q = nwg / NXCD, r = nwg % NXCD, xcd = wgid % NXCD, off = wgid / NXCD; wgid = (xcd < r ? xcd * (q + 1) : r * (q + 1) + (xcd - r) * q) + off; }
        const int nig = WGM * nN, gid = wgid / nig, fm = gid * WGM, gsz = (nM - fm) < WGM ? (nM - fm) : WGM;
        u.pm = fm + ((wgid % nig) % gsz); u.pn = (wgid % nig) / gsz; u.e = 0; u.rb = 0; u.cnt = 256; return true;
    }
    __device__ __forceinline__ const char* a_ptr(const Unit& u) const { return (const char*)A + (size_t)u.pm * (size_t)(2 * HALF) * K * 2; }
    __device__ __forceinline__ const char* b_ptr(const Unit& u) const { return (const char*)Bt + (size_t)u.pn * (size_t)(2 * HALF) * K * 2; }
    __device__ __forceinline__ void gather_off(const Unit&, int, unsigned (&)[2][2]) const {}
};
template <bool GATH> struct MoeSched {
    static constexpr bool GATHER = GATH;
    const bf16* A; const bf16* W; int K; int NT;
    const int* lists; const LAS int* tab; int G, c, U;
    __device__ __forceinline__ bool next(int i, Unit& u) const {
        const long L = (long)i * G + c; if (L >= U) return false;
        int wgid = (int)L; { const int q = U / NXCD, r = U % NXCD, xcd = wgid % NXCD, off = wgid / NXCD; wgid = (xcd < r ? xcd * (q + 1) : r * (q + 1) + (xcd - r) * q) + off; }
        int e = 0;
#pragma unroll 1
        for (int k = 1; k < 32; ++k) { if (tab[32 + k] * NT <= wgid) e = k; }
        const int rb0 = tab[32 + e], nb = tab[32 + e + 1] - rb0, j = wgid - rb0 * NT;
        u.e = e; u.pn = j / nb; u.rb = j % nb; u.pm = rb0 + u.rb; u.cnt = tab[e] - u.rb * 256; return true;
    }
    __device__ __forceinline__ const char* a_ptr(const Unit& u) const { return GATH ? (const char*)A : (const char*)A + (size_t)u.pm * (size_t)(2 * HALF) * K * 2; }
    __device__ __forceinline__ const char* b_ptr(const Unit& u) const { return (const char*)W + ((size_t)u.e * NT + u.pn) * (size_t)(2 * HALF) * K * 2; }
    __device__ __forceinline__ void gather_off(const Unit& u, int tid, unsigned (&v)[2][2]) const {
#pragma unroll
        for (int i = 0; i < 2; ++i) { int R, C; stage_rc(tid * 16 + i * 8192, R, C);
#pragma unroll
            for (int h = 0; h < 2; ++h) { const int row = R + 128 * h; int tok = 0; if (row < u.cnt) tok = lists[(size_t)u.e * LSTRIDE + u.rb * 256 + row] >> 2; v[h][i] = (unsigned)tok * (unsigned)(K * 2) + (unsigned)(C * 2); } }
    }
};

template <class Epi, class Sched>
__device__ __forceinline__ void gemm_phase(LAS unsigned char* lds, const Sched& S, const Epi& E) {
    const int tid = threadIdx.x, wid = __builtin_amdgcn_readfirstlane(tid >> 6), lane = tid & 63, wr = wid >> 2, wc = wid & 3, fr = lane & 15, fq = lane >> 4;
    const int K = S.K, nt = K / BK;
    unsigned voffA[2], voffB[2];
#pragma unroll
    for (int i = 0; i < 2; ++i) { int R, C; stage_rc(tid * 16 + i * 8192, R, C); const int Rb = Epi::PERM ? ((R & ~31) + perm32(R & 31)) : R;
        voffA[i] = (unsigned)(R * K + C) * 2u; voffB[i] = (unsigned)(Rb * K + C) * 2u; }
    const size_t kstep = (size_t)(BK * 2);
    const size_t hstep = (size_t)HALF * K * 2;
    const unsigned ldsw = (unsigned)wid * 1024u;
    const int aoff = lds_byte(wr * 64 + fr, fq * 8), boff = lds_byte(wc * 32 + fr, fq * 8);
#define PG8_SA(b, h) (((b) * 2 + (h)) * HTB)
#define PG8_SB(b, h) ((4 + (b) * 2 + (h)) * HTB)
#define PG8_GLDS(gp, off) __builtin_amdgcn_global_load_lds((const unsigned*)(gp), (LAS unsigned*)(lds + (off)), 16, 0, 0)
#define PG8_STAGE_B(bufoff, gbase) do { _Pragma("unroll") for (int _i = 0; _i < 2; ++_i) PG8_GLDS((const char*)(gbase) + voffB[_i], (bufoff) + ldsw + _i * 8192); } while (0)
#define PG8_STAGE_A(bufoff, h, kp) do { if constexpr (Sched::GATHER) { _Pragma("unroll") for (int _i = 0; _i < 2; ++_i) PG8_GLDS((const char*)(kp) + vAc[h][_i], (bufoff) + ldsw + _i * 8192); } \
        else { _Pragma("unroll") for (int _i = 0; _i < 2; ++_i) PG8_GLDS((const char*)(kp) + (h) * hstep + voffA[_i], (bufoff) + ldsw + _i * 8192); } } while (0)
#define PG8_LDA(dst, b, h) do { _Pragma("unroll") for (int m = 0; m < 4; ++m) _Pragma("unroll") for (int k = 0; k < 2; ++k) dst[m][k] = *(const LAS bf16x8*)(lds + PG8_SA(b, h) + aoff + m * 2048 + k * 1024); } while (0)
#define PG8_LDB(dst, b, h) do { _Pragma("unroll") for (int n = 0; n < 2; ++n) _Pragma("unroll") for (int k = 0; k < 2; ++k) dst[n][k] = *(const LAS bf16x8*)(lds + PG8_SB(b, h) + boff + n * 2048 + k * 1024); } while (0)
#define PG8_MMA(ai, bj, At, Bt) do { __builtin_amdgcn_s_setprio(1); _Pragma("unroll") for (int m = 0; m < 4; ++m) _Pragma("unroll") for (int n = 0; n < 2; ++n) _Pragma("unroll") for (int k = 0; k < 2; ++k) \
        acc[ai][bj][m][n] = __builtin_amdgcn_mfma_f32_16x16x32_bf16(Bt[n][k], At[m][k], acc[ai][bj][m][n], 0, 0, 0); __builtin_amdgcn_s_setprio(0); } while (0)
#define PG8_WAIT_V(n) asm volatile("s_waitcnt vmcnt(" #n ")" ::: "memory")
#define PG8_WAIT_L(n) asm volatile("s_waitcnt lgkmcnt(" #n ")" ::: "memory")
#define PG8_BAR __builtin_amdgcn_s_barrier()
#define PG8_SCHED __builtin_amdgcn_sched_barrier(0)
    Unit cur, nxt; int ui = 0;
    if (!S.next(0, cur)) return;
    f32x4 acc[2][2][4][2];
#pragma unroll
    for (int a = 0; a < 2; ++a)
#pragma unroll
        for (int b = 0; b < 2; ++b)
#pragma unroll
            for (int m = 0; m < 4; ++m)
#pragma unroll
                for (int n = 0; n < 2; ++n) acc[a][b][m][n] = (f32x4){0.f, 0.f, 0.f, 0.f};
    bf16x8 At[4][2], B0[2][2], B1[2][2];
    unsigned vAc[2][2] = {{0u, 0u}, {0u, 0u}};
    if constexpr (Sched::GATHER) { S.gather_off(cur, tid, vAc); }
    const char* cA = S.a_ptr(cur); const char* cB = S.b_ptr(cur);
    PG8_STAGE_B(PG8_SB(0, 0), cB); PG8_STAGE_B(PG8_SB(0, 1), cB + hstep); PG8_STAGE_A(PG8_SA(0, 0), 0, cA); PG8_STAGE_A(PG8_SA(0, 1), 1, cA);
    if (wr == 1) PG8_BAR;
    PG8_WAIT_V(2); PG8_BAR;
    PG8_STAGE_B(PG8_SB(1, 0), cB + kstep); PG8_STAGE_A(PG8_SA(1, 0), 0, cA + kstep); PG8_STAGE_B(PG8_SB(1, 1), cB + hstep + kstep);
    PG8_WAIT_V(6); PG8_BAR;
    for (;;) {
        const bool has_next = S.next(ui + 1, nxt);
        const char* nA = has_next ? S.a_ptr(nxt) : cA; const char* nB = has_next ? S.b_ptr(nxt) : cB;
        for (int t = 0; t < nt; t += 2) {
            const bool last = (t == nt - 2);
            const char* a1 = cA + (size_t)(t + 1) * kstep;
            const char* a2 = last ? nA : cA + (size_t)(t + 2) * kstep; const char* b2 = last ? nB : cB + (size_t)(t + 2) * kstep;
            const char* a3 = a2 + kstep; const char* b3 = b2 + kstep;
            PG8_LDB(B0, 0, 0); PG8_LDB(B1, 0, 1); PG8_SCHED; PG8_LDA(At, 0, 0); PG8_STAGE_A(PG8_SA(1, 1), 1, a1);
            if constexpr (Sched::GATHER) { if (last && has_next) S.gather_off(nxt, tid, vAc); }
            PG8_WAIT_V(8); PG8_WAIT_L(0); PG8_BAR; PG8_MMA(0, 0, At, B0); PG8_MMA(0, 1, At, B1); PG8_BAR; PG8_SCHED;
            PG8_LDA(At, 0, 1); PG8_STAGE_B(PG8_SB(0, 0), b2); PG8_STAGE_B(PG8_SB(0, 1), b2 + hstep); PG8_STAGE_A(PG8_SA(0, 0), 0, a2);
            PG8_WAIT_V(8); PG8_WAIT_L(0); PG8_BAR; PG8_MMA(1, 0, At, B0); PG8_MMA(1, 1, At, B1); PG8_BAR; PG8_SCHED;
            PG8_LDB(B0, 1, 0); PG8_LDB(B1, 1, 1); PG8_SCHED; PG8_LDA(At, 1, 0); PG8_STAGE_A(PG8_SA(0, 1), 1, a2);
            PG8_WAIT_V(8); PG8_WAIT_L(0); PG8_BAR; PG8_MMA(0, 0, At, B0); PG8_MMA(0, 1, At, B1); PG8_BAR; PG8_SCHED;
            PG8_LDA(At, 1, 1); PG8_STAGE_B(PG8_SB(1, 0), b3); PG8_STAGE_B(PG8_SB(1, 1), b3 + hstep); PG8_STAGE_A(PG8_SA(1, 0), 0, a3);
            PG8_WAIT_V(8); PG8_WAIT_L(0); PG8_BAR; PG8_MMA(1, 0, At, B0); PG8_MMA(1, 1, At, B1); PG8_BAR; PG8_SCHED;
        }
        if (wr == 0) PG8_BAR;
        E(acc, cur, wr, wc, fr, fq);
        if (!has_next) break;
#pragma unroll
        for (int a = 0; a < 2; ++a)
#pragma unroll
            for (int b = 0; b < 2; ++b)
#pragma unroll
                for (int m = 0; m < 4; ++m)
#pragma unroll
                    for (int n = 0; n < 2; ++n) acc[a][b][m][n] = (f32x4){0.f, 0.f, 0.f, 0.f};
        cur = nxt; cA = nA; cB = nB; ++ui;
        if (wr == 1) PG8_BAR;
    }
    PG8_WAIT_V(0);
    PG8_BAR;
#undef PG8_SA
#undef PG8_SB
#undef PG8_GLDS
#undef PG8_STAGE_A
#undef PG8_STAGE_B
#undef PG8_LDA
#undef PG8_LDB
#undef PG8_MMA
#undef PG8_WAIT_V
#undef PG8_WAIT_L
#undef PG8_BAR
#undef PG8_SCHED
}
}

struct EpiZ {
    static constexpr bool PERM = true;
    bf16* Z; const float* lb;
    __device__ __forceinline__ void operator()(const f32x4 (&acc)[2][2][4][2], const pg8::Unit& u, int wr, int wc, int fr, int fq) const {
        const int row0 = u.pm * 256 + wr * 64 + fr, seg = u.pn >> 1, col0 = u.pn * 256 + wc * 32 + 8 * fq;
        f32x4 lbv[2][2];
#pragma unroll
        for (int bj = 0; bj < 2; ++bj)
#pragma unroll
            for (int n = 0; n < 2; ++n) lbv[bj][n] = (seg == 1) ? *(const f32x4*)(lb + (col0 - 512) + bj * 128 + 4 * n) : (f32x4){0.f, 0.f, 0.f, 0.f};
#pragma unroll
        for (int ai = 0; ai < 2; ++ai)
#pragma unroll
            for (int m = 0; m < 4; ++m) { bf16* rowp = Z + (size_t)(row0 + ai * 128 + m * 16) * NIN + col0;
#pragma unroll
                for (int bj = 0; bj < 2; ++bj) { f32x4 v0 = acc[ai][bj][m][0], v1 = acc[ai][bj][m][1];
                    if (seg == 1) {
#pragma unroll
                        for (int j = 0; j < 4; ++j) { const float l0 = lbv[bj][0][j], l1 = lbv[bj][1][j];
                            v0[j] = __logf(l0 + (1.0f - l0) * fsigmoid(v0[j])); v1[j] = __logf(l1 + (1.0f - l1) * fsigmoid(v1[j])); }
                    } else if (seg == 3) {
#pragma unroll
                        for (int j = 0; j < 4; ++j) { v0[j] = v0[j] * fsigmoid(v0[j]); v1[j] = v1[j] * fsigmoid(v1[j]); }
                    } else if (seg >= 4) {
                        f32x2 a = gelu_pk((f32x2){v0[0], v0[1]}), b = gelu_pk((f32x2){v0[2], v0[3]}), c = gelu_pk((f32x2){v1[0], v1[1]}), d = gelu_pk((f32x2){v1[2], v1[3]});
                        v0 = (f32x4){a.x, a.y, b.x, b.y}; v1 = (f32x4){c.x, c.y, d.x, d.y};
                    }
                    u32x4 w; w.x = pk2(v0[0], v0[1]); w.y = pk2(v0[2], v0[3]); w.z = pk2(v1[0], v1[1]); w.w = pk2(v1[2], v1[3]);
                    *(u32x4*)(rowp + bj * 128) = w; } }
    }
};
struct EpiXmid {
    static constexpr bool PERM = false;
    const float* x; float* xmid; const float* mod;
    __device__ __forceinline__ void operator()(const f32x4 (&acc)[2][2][4][2], const pg8::Unit& u, int wr, int wc, int fr, int fq) const {
        const int row0 = u.pm * 256 + wr * 64 + fr, col0 = u.pn * 256 + wc * 32 + 4 * fq, b = (u.pm * 256) / SEQ;
        f32x4 gv[2][2];
#pragma unroll
        for (int bj = 0; bj < 2; ++bj)
#pragma unroll
            for (int n = 0; n < 2; ++n) gv[bj][n] = *(const f32x4*)(mod + b * 6144 + 2048 + col0 + bj * 128 + n * 16);
#pragma unroll
        for (int ai = 0; ai < 2; ++ai)
#pragma unroll
            for (int m = 0; m < 4; ++m) { const size_t off = (size_t)(row0 + ai * 128 + m * 16) * DM + col0;
#pragma unroll
                for (int bj = 0; bj < 2; ++bj)
#pragma unroll
                    for (int n = 0; n < 2; ++n) { const f32x4 xv = *(const f32x4*)(x + off + bj * 128 + n * 16); *(f32x4*)(xmid + off + bj * 128 + n * 16) = xv + gv[bj][n] * acc[ai][bj][m][n]; } }
    }
};
struct EpiAct {
    static constexpr bool PERM = true;
    bf16* act; const float* bgu;
    __device__ __forceinline__ void operator()(const f32x4 (&acc)[2][2][4][2], const pg8::Unit& u, int wr, int wc, int fr, int fq) const {
        const int row0 = u.pm * 256 + wr * 64 + fr, c0 = u.pn * 128 + wc * 32 + 8 * fq;
        const float* bg = bgu + (size_t)u.e * 2048 + c0;
        f32x4 bgv[2], buv[2];
#pragma unroll
        for (int n = 0; n < 2; ++n) { bgv[n] = *(const f32x4*)(bg + 4 * n); buv[n] = *(const f32x4*)(bg + 1024 + 4 * n); }
#pragma unroll
        for (int ai = 0; ai < 2; ++ai)
#pragma unroll
            for (int m = 0; m < 4; ++m) { bf16* rowp = act + (size_t)(row0 + ai * 128 + m * 16) * DFF + c0;
                float o[8];
#pragma unroll
                for (int n = 0; n < 2; ++n)
#pragma unroll
                    for (int j = 0; j < 4; ++j) { float g = acc[ai][0][m][n][j] + bgv[n][j], up = acc[ai][1][m][n][j] + buv[n][j];
                        g = fminf(g, SW_LIMIT); up = fminf(fmaxf(up, -SW_LIMIT), SW_LIMIT);
                        const float glu = g * fsigmoid(SW_ALPHA * g); o[4 * n + j] = (up + 1.0f) * glu; }
                u32x4 w; w.x = pk2(o[0], o[1]); w.y = pk2(o[2], o[3]); w.z = pk2(o[4], o[5]); w.w = pk2(o[6], o[7]);
                *(u32x4*)rowp = w; }
    }
};
struct EpiDown {
    static constexpr bool PERM = true;
    bf16* yslot; const float* bd; const float* gates; const int* lists;
    __device__ __forceinline__ void operator()(const f32x4 (&acc)[2][2][4][2], const pg8::Unit& u, int wr, int wc, int fr, int fq) const {
        const int rl0 = wr * 64 + fr, col0 = u.pn * 256 + wc * 32 + 8 * fq;
        f32x4 bv[2][2];
#pragma unroll
        for (int bj = 0; bj < 2; ++bj)
#pragma unroll
            for (int n = 0; n < 2; ++n) bv[bj][n] = *(const f32x4*)(bd + (size_t)u.e * DM + col0 + bj * 128 + 4 * n);
#pragma unroll
        for (int ai = 0; ai < 2; ++ai)
#pragma unroll
            for (int m = 0; m < 4; ++m) { const int rl = rl0 + ai * 128 + m * 16;
                if (rl < u.cnt) { const int slot = lists[(size_t)u.e * LSTRIDE + u.rb * 256 + rl]; const float gw = gates[slot];
                    bf16* rowp = yslot + (size_t)slot * DM + col0;
#pragma unroll
                    for (int bj = 0; bj < 2; ++bj) { const f32x4 v0 = (acc[ai][bj][m][0] + bv[bj][0]) * gw, v1 = (acc[ai][bj][m][1] + bv[bj][1]) * gw;
                        u32x4 w; w.x = pk2(v0[0], v0[1]); w.y = pk2(v0[2], v0[3]); w.z = pk2(v1[0], v1[1]); w.w = pk2(v1[2], v1[3]);
                        *(u32x4*)(rowp + bj * 128) = w; } } }
    }
};

#define XB_TMO      128
#define XB_XCNT(j)  (256  + 64 * (j))
#define XB_XSUB(j)  (1280 + 64 * (j))
#define XB_XGEN(j)  (2304 + 64 * (j))
#define XB_TOP      3328
#define XB_TOPGEN   3392
#define XCD_BAR_WORDS 3456
#define XB_SPIN_CAP (1u << 18)
__device__ __forceinline__ unsigned xb_ld(unsigned* p)              { return __hip_atomic_load(p, __ATOMIC_RELAXED, __HIP_MEMORY_SCOPE_AGENT); }
__device__ __forceinline__ unsigned xb_add(unsigned* p, unsigned v) { return __hip_atomic_fetch_add(p, v, __ATOMIC_RELAXED, __HIP_MEMORY_SCOPE_AGENT); }
__device__ __forceinline__ unsigned xb_xcc_id() { return (unsigned)__builtin_amdgcn_s_getreg((3 << 11) | 20) & 0xFu; }
#define XB_SPIN(cond, bar) do { unsigned _sp = 0; while (cond) { __builtin_amdgcn_s_sleep(1); \
    if ((++_sp & 255u) == 0u) { if (xb_ld(&(bar)[XB_TMO])) break; if (_sp > XB_SPIN_CAP) { atomicAdd(&(bar)[XB_TMO], 1u); break; } } } } while (0)
struct XcdBarrier { unsigned* bar; unsigned x; volatile LAS unsigned* st; };
__device__ __forceinline__ XcdBarrier xcd_barrier_post(unsigned* bar, volatile LAS unsigned* st) {
    XcdBarrier b; b.bar = bar; b.x = xb_xcc_id(); b.st = st;
    if (threadIdx.x == 0) (void)xb_add(&bar[XB_XCNT(b.x)], 1u);
    return b;
}
__device__ __forceinline__ void xcd_barrier_complete(unsigned* bar, unsigned x, unsigned& nloc, unsigned& nx) {
    const unsigned G = gridDim.x * gridDim.y * gridDim.z;
    unsigned sum, cnt, mine, sp = 0u;
    for (;;) {
        sum = 0u; cnt = 0u; mine = 0u;
#pragma unroll
        for (unsigned j = 0; j < 16; ++j) { const unsigned c = xb_ld(&bar[XB_XCNT(j)]); sum += c; cnt += (c > 0u) ? 1u : 0u; mine = (j == x) ? c : mine; }
        if (sum == G) break;
        __builtin_amdgcn_s_sleep(1);
        if ((++sp & 255u) == 0u) { if (xb_ld(&bar[XB_TMO])) break; if (sp > XB_SPIN_CAP) { atomicAdd(&bar[XB_TMO], 1u); break; } }
    }
    nloc = mine > 0u ? mine : 1u; nx = cnt > 0u ? cnt : 1u;
}
__device__ __forceinline__ void xcd_barrier(const XcdBarrier& b) {
    asm volatile("s_waitcnt vmcnt(0)" ::: "memory");
    __syncthreads();
    if (threadIdx.x == 0) {
        unsigned* bar = b.bar;
        __builtin_amdgcn_s_waitcnt(0);
        unsigned nloc = b.st[0], nx = b.st[1];
        if (nloc == 0u) { xcd_barrier_complete(bar, b.x, nloc, nx); b.st[0] = nloc; b.st[1] = nx; }
        const unsigned old = xb_add(&bar[XB_XSUB(b.x)], 1u);
        const unsigned gen = old / nloc;
        if (old + 1u == (gen + 1u) * nloc) {
            __builtin_amdgcn_fence(__ATOMIC_RELEASE, "agent");
            asm volatile("s_waitcnt vmcnt(0)" ::: "memory");
            const unsigned og = xb_add(&bar[XB_TOP], 1u);
            const unsigned tg = og / nx;
            if (og + 1u == (tg + 1u) * nx) xb_add(&bar[XB_TOPGEN], 1u);
            else XB_SPIN(xb_ld(&bar[XB_TOPGEN]) == tg, bar);
            __builtin_amdgcn_fence(__ATOMIC_ACQUIRE, "agent");
            xb_add(&bar[XB_XGEN(b.x)], 1u);
            asm volatile("s_waitcnt vmcnt(0)" ::: "memory");
        } else {
            XB_SPIN(xb_ld(&bar[XB_XGEN(b.x)]) == gen, bar);
            __builtin_amdgcn_fence(__ATOMIC_ACQUIRE, "agent");
            asm volatile("s_waitcnt vmcnt(0)" ::: "memory");
        }
    }
    __syncthreads();
}

struct Args { const float* in[22]; float* out; unsigned char* ws; int ph_lo, ph_hi; };
enum { I_X = 0, I_C, I_ADAW, I_ADAB, I_NMG, I_WIN, I_LBP, I_HNG, I_LNG, I_LNB, I_GWS, I_GBS, I_GNG, I_WOUT, I_NFG, I_RW, I_RB, I_WGU, I_BGU, I_WD, I_BD, I_FG };

template <bool GU>
__device__ __forceinline__ void cvt_item(const float* W, int K, int N, bf16* WT, int item, int lane) {
    const int nblk = N / 64, kb = item / nblk, nb = item - kb * nblk, k0 = 64 * kb, n0 = 64 * nb, q = lane >> 4, c = lane & 15;
    const float* src = W + (size_t)(k0 + 16 * q) * N + n0 + 4 * c;
    f32x4 v[16];
#pragma unroll
    for (int i = 0; i < 16; ++i) v[i] = __builtin_nontemporal_load((const f32x4*)(src + (size_t)i * N));
#pragma unroll
    for (int j = 0; j < 4; ++j) { const int n = n0 + 4 * c + j; int np = n;
        if (GU) { const int hi = n >= 1024, nn = n - hi * 1024; np = ((nn >> 7) << 8) + hi * 128 + (nn & 127); }
        u32x4 lo, hi4;
        lo.x = pk2(v[0][j], v[1][j]); lo.y = pk2(v[2][j], v[3][j]); lo.z = pk2(v[4][j], v[5][j]); lo.w = pk2(v[6][j], v[7][j]);
        hi4.x = pk2(v[8][j], v[9][j]); hi4.y = pk2(v[10][j], v[11][j]); hi4.z = pk2(v[12][j], v[13][j]); hi4.w = pk2(v[14][j], v[15][j]);
        bf16* dst = WT + (size_t)np * K + k0 + 16 * q;
        *(u32x4*)dst = lo; *(u32x4*)(dst + 8) = hi4; }
}
__device__ __forceinline__ void p0_prologue(const Args& a, LAS unsigned char* lds, int vcu, int G, int tid, int wave, int lane) {
    unsigned char* ws = a.ws;
    if (vcu < 96) {
        LAS float* cact = (LAS float*)lds;
        LAS float* ps = (LAS float*)(lds + 16384);
        for (int i = tid; i < 4096; i += 512) { const float cv = a.in[I_C][i]; cact[i] = cv * fsigmoid(cv); }
        __syncthreads();
        const float* w = a.in[I_ADAW] + (size_t)(128 * wave) * 6144 + 64 * vcu + lane;
        float s0 = 0.f, s1 = 0.f, s2 = 0.f, s3 = 0.f;
#pragma unroll 16
        for (int k = 0; k < 128; ++k) { const float wv = w[(size_t)k * 6144]; const int kk = 128 * wave + k;
            s0 += cact[kk] * wv; s1 += cact[1024 + kk] * wv; s2 += cact[2048 + kk] * wv; s3 += cact[3072 + kk] * wv; }
        ps[(wave * 4 + 0) * 64 + lane] = s0; ps[(wave * 4 + 1) * 64 + lane] = s1; ps[(wave * 4 + 2) * 64 + lane] = s2; ps[(wave * 4 + 3) * 64 + lane] = s3;
        __syncthreads();
        if (wave < 4) { float s = a.in[I_ADAB][64 * vcu + lane];
#pragma unroll
            for (int w8 = 0; w8 < 8; ++w8) s += ps[(w8 * 4 + wave) * 64 + lane];
            ((float*)(ws + WS_MOD))[wave * 6144 + 64 * vcu + lane] = s; }
        __syncthreads();
    }
    if (vcu == G - 1) { const float p0 = a.in[I_LBP][tid], p1 = a.in[I_LBP][512 + tid]; ((float*)(ws + WS_LB))[tid] = fsigmoid(p0 - p1); }
    const int gw = vcu * 8 + wave, NGW = G * 8;
    constexpr int I_IN = 16 * 48, I_OUT = 16 * 16, I_GU = 16 * 32, I_DN = 16 * 16;
    constexpr int NITEMS = I_IN + I_OUT + NE * (I_GU + I_DN);
    for (int it = gw; it < NITEMS; it += NGW) {
        int r = it;
        if (r < I_IN) { cvt_item<false>(a.in[I_WIN], DM, NIN, (bf16*)(ws + WS_WIN), r, lane); continue; } r -= I_IN;
        if (r < I_OUT) { cvt_item<false>(a.in[I_WOUT], DM, DM, (bf16*)(ws + WS_WOUT), r, lane); continue; } r -= I_OUT;
        if (r < NE * I_GU) { const int e = r / I_GU; cvt_item<true>(a.in[I_WGU] + (size_t)e * DM * 2048, DM, 2048, (bf16*)(ws + WS_WGU) + (size_t)e * 2048 * DM, r - e * I_GU, lane); continue; } r -= NE * I_GU;
        { const int e = r / I_DN; cvt_item<false>(a.in[I_WD] + (size_t)e * DFF * DM, DFF, DM, (bf16*)(ws + WS_WD) + (size_t)e * DM * DFF, r - e * I_DN, lane); }
    }
}

__device__ __forceinline__ void p1_h1(const Args& a, int vcu, int G, int wave, int lane) {
    const int gw = vcu * 8 + wave, NGW = G * 8;
    const float* mod = (const float*)(a.ws + WS_MOD);
    bf16* H = (bf16*)(a.ws + WS_H);
    for (int m = gw; m < MT; m += NGW) {
        const int b = m / SEQ;
        const f32x4* xr = (const f32x4*)(a.in[I_X] + (size_t)m * DM) + lane;
        f32x4 v[4]; float ss = 0.f;
#pragma unroll
        for (int j = 0; j < 4; ++j) { v[j] = xr[64 * j]; ss += (v[j].x * v[j].x + v[j].y * v[j].y) + (v[j].z * v[j].z + v[j].w * v[j].w); }
        const float rstd = rsqrtf(wave_sum(ss) * (1.0f / DM) + EPS);
        u32x2* o8 = (u32x2*)(H + (size_t)m * DM) + lane;
#pragma unroll
        for (int j = 0; j < 4; ++j) { const int c = 4 * lane + 256 * j;
            const f32x4 g = *(const f32x4*)(a.in[I_NMG] + c), sh = *(const f32x4*)(mod + b * 6144 + c), sc = *(const f32x4*)(mod + b * 6144 + 1024 + c);
            const f32x4 h = (v[j] * rstd) * g * (sc + 1.0f) + sh;
            u32x2 w; w.x = pk2(h.x, h.y); w.y = pk2(h.z, h.w); o8[64 * j] = w; }
    }
}

__device__ __forceinline__ void p6_router(const Args& a, LAS unsigned char* lds, int vcu, int G, int tid, int wave, int lane) {
    LAS float* wl = (LAS float*)lds;
    LAS int* sel_e = (LAS int*)(lds + 131584);
    LAS int* sel_p = sel_e + 256;
    LAS int* hist = sel_p + 256;
    LAS int* base = hist + 32;
    const float* rw = a.in[I_RW];
    for (int idx = tid; idx < 8192; idx += 512) { const int i = idx >> 3, e4 = idx & 7; const f32x4 w = ((const f32x4*)rw)[idx];
        wl[(4 * e4 + 0) * 1028 + i] = w.x; wl[(4 * e4 + 1) * 1028 + i] = w.y; wl[(4 * e4 + 2) * 1028 + i] = w.z; wl[(4 * e4 + 3) * 1028 + i] = w.w; }
    if (tid < 32) hist[tid] = 0;
    __syncthreads();
    const float* mod = (const float*)(a.ws + WS_MOD);
    const float* xmid = (const float*)(a.ws + WS_XMID);
    bf16* H = (bf16*)(a.ws + WS_H);
    float* gates = (float*)(a.ws + WS_GATES);
    int* lists = (int*)(a.ws + WS_LISTS);
    unsigned* cntg = (unsigned*)(a.ws + WS_CTL) + CW_CNT;
    const int RPB = (MT + G - 1) / G, row_base = vcu * RPB;
    for (int pr = wave; 2 * pr < RPB; pr += 8) {
        const int r0 = row_base + 2 * pr;
        f32x4 v[2][4];
#pragma unroll
        for (int r = 0; r < 2; ++r) { const int m = (r0 + r < MT && 2 * pr + r < RPB) ? r0 + r : 0; const int b = m / SEQ;
            const f32x4* xr = (const f32x4*)(xmid + (size_t)m * DM) + lane; float ss = 0.f;
#pragma unroll
            for (int j = 0; j < 4; ++j) { v[r][j] = xr[64 * j]; ss += (v[r][j].x * v[r][j].x + v[r][j].y * v[r][j].y) + (v[r][j].z * v[r][j].z + v[r][j].w * v[r][j].w); }
            const float rstd = rsqrtf(wave_sum(ss) * (1.0f / DM) + EPS);
            u32x2* o8 = (u32x2*)(H + (size_t)m * DM) + lane;
#pragma unroll
            for (int j = 0; j < 4; ++j) { const int c = 4 * lane + 256 * j;
                const f32x4 g = *(const f32x4*)(a.in[I_NFG] + c), sh = *(const f32x4*)(mod + b * 6144 + 3072 + c), sc = *(const f32x4*)(mod + b * 6144 + 4096 + c);
                v[r][j] = (v[r][j] * rstd) * g * (sc + 1.0f) + sh;
                if (r0 + r < MT && 2 * pr + r < RPB) { u32x2 w; w.x = pk2(v[r][j].x, v[r][j].y); w.y = pk2(v[r][j].z, v[r][j].w); o8[64 * j] = w; } }
        }
        float tot[2][4];
#pragma unroll
        for (int g = 0; g < 4; ++g) {
            float p8[2][8];
#pragma unroll
            for (int i = 0; i < 8; ++i) { float s0 = 0.f, s1 = 0.f;
#pragma unroll
                for (int j = 0; j < 4; ++j) { const f32x4 w = *(const LAS f32x4*)(wl + (8 * g + i) * 1028 + 4 * lane + 256 * j);
                    s0 += (v[0][j].x * w.x + v[0][j].y * w.y) + (v[0][j].z * w.z + v[0][j].w * w.w);
                    s1 += (v[1][j].x * w.x + v[1][j].y * w.y) + (v[1][j].z * w.z + v[1][j].w * w.w); }
                p8[0][i] = s0; p8[1][i] = s1; }
#pragma unroll
            for (int r = 0; r < 2; ++r) {
                float q4[4], q2[2], t;
                { const bool up = (lane & 32) != 0;
#pragma unroll
                  for (int i = 0; i < 4; ++i) { const float snd = up ? p8[r][i] : p8[r][4 + i], mine = up ? p8[r][4 + i] : p8[r][i]; q4[i] = mine + __shfl_xor(snd, 32); } }
                { const bool up = (lane & 16) != 0;
#pragma unroll
                  for (int i = 0; i < 2; ++i) { const float snd = up ? q4[i] : q4[2 + i], mine = up ? q4[2 + i] : q4[i]; q2[i] = mine + __shfl_xor(snd, 16); } }
                { const bool up = (lane & 8) != 0; const float snd = up ? q2[0] : q2[1], mine = up ? q2[1] : q2[0]; t = mine + __shfl_xor(snd, 8); }
                t += __shfl_xor(t, 4); t += __shfl_xor(t, 2); t += __shfl_xor(t, 1);
                tot[r][g] = t; }
            asm volatile("" ::: "memory");
        }
#pragma unroll
        for (int r = 0; r < 2; ++r) {
            const int e_me = lane & 31, gi = e_me >> 3, srcl = 8 * (e_me & 7);
            const float t0 = __shfl(tot[r][0], srcl), t1 = __shfl(tot[r][1], srcl), t2 = __shfl(tot[r][2], srcl), t3 = __shfl(tot[r][3], srcl);
            const float val = (gi == 0 ? t0 : gi == 1 ? t1 : gi == 2 ? t2 : t3) + a.in[I_RB][e_me];
            int rank = 0;
#pragma unroll
            for (int e2 = 0; e2 < 32; ++e2) { const float o = __builtin_bit_cast(float, __builtin_amdgcn_readlane(__builtin_bit_cast(int, val), e2)); rank += (o > val || (o == val && e2 < e_me)) ? 1 : 0; }
            int te[4]; float tv[4];
#pragma unroll
            for (int k = 0; k < 4; ++k) { const unsigned long long mk = __ballot(rank == k && lane < 32); const int src = mk ? (int)__builtin_ctzll(mk) : 0;
                te[k] = src; tv[k] = __builtin_bit_cast(float, __builtin_amdgcn_readlane(__builtin_bit_cast(int, val), src)); }
            const float e1 = __expf(tv[1] - tv[0]), e2x = __expf(tv[2] - tv[0]), e3 = __expf(tv[3] - tv[0]);
            const float inv = __frcp_rn(1.0f + e1 + e2x + e3);
            const bool valid = (r0 + r < MT && 2 * pr + r < RPB);
            if (valid && lane < 4) { const float gsel = lane == 0 ? 1.0f : lane == 1 ? e1 : lane == 2 ? e2x : e3; const int esel = lane == 0 ? te[0] : lane == 1 ? te[1] : lane == 2 ? te[2] : te[3];
                gates[(size_t)(r0 + r) * 4 + lane] = gsel * inv;
                const int li = (2 * pr + r) * 4 + lane; sel_e[li] = esel; sel_p[li] = __hip_atomic_fetch_add(&hist[esel], 1, __ATOMIC_RELAXED, __HIP_MEMORY_SCOPE_WORKGROUP); }
        }
    }
    __syncthreads();
    if (tid < 32) base[tid] = (int)__hip_atomic_fetch_add(cntg + 64 * tid, (unsigned)hist[tid], __ATOMIC_RELAXED, __HIP_MEMORY_SCOPE_AGENT);
    __syncthreads();
    for (int li = tid; li < RPB * 4; li += 512) { const int t = row_base + (li >> 2); if (t < MT) { const int e = sel_e[li]; lists[(size_t)e * LSTRIDE + base[e] + sel_p[li]] = t * 4 + (li & 3); } }
}

typedef __attribute__((__vector_size__(8 * sizeof(short)))) short bf16x8v;
constexpr int HG_T = 0;
constexpr int HG_QT = 4096;
constexpr int HG_QH = HG_QT + 17408;
constexpr int HG_KH = HG_QH + 17408;
constexpr int HG_VT = HG_KH + 43520;
constexpr int HG_KD = HG_VT + 18432;
constexpr int HG_SS = HG_KD + 18432;
static_assert(HG_SS + 512 <= LDSCTL_OFF, "hgrn lds");
__device__ __forceinline__ bf16x8 mk_frag(unsigned a, unsigned b, unsigned c, unsigned d) { u32x4 w = {a, b, c, d}; return __builtin_bit_cast(bf16x8, w); }

__device__ __forceinline__ void hgrnA_unit(const bf16* Z, bf16* KVT, float* DEC, LAS unsigned char* lds, int unit, int wave, int lane) {
    const int bh = unit >> 6, c = unit & 63, b = bh >> 2, h = bh & 3, fr = lane & 15, q = lane >> 4;
    const bf16* zp = Z + ((size_t)b * SEQ + c * 64 + 8 * wave) * NIN + h * 128 + 2 * lane;
    float lf0[8], lf1[8]; unsigned vw[8];
#pragma unroll
    for (int i = 0; i < 8; ++i) { const unsigned w = *(const unsigned*)(zp + (size_t)i * NIN + 512); lf0[i] = bflo(w); lf1[i] = bfhi(w); vw[i] = *(const unsigned*)(zp + (size_t)i * NIN + 1024); }
    float p0[8], p1[8]; { float r0 = 0.f, r1 = 0.f;
#pragma unroll
        for (int i = 0; i < 8; ++i) { r0 += lf0[i]; r1 += lf1[i]; p0[i] = r0; p1[i] = r1; } }
    LAS float* T = (LAS float*)(lds + HG_T);
    *(LAS f32x2*)(T + wave * 128 + 2 * lane) = (f32x2){p0[7], p1[7]};
    __syncthreads();
    float off0 = 0.f, off1 = 0.f, tot0 = 0.f, tot1 = 0.f;
#pragma unroll
    for (int w = 0; w < 8; ++w) { const f32x2 t = *(const LAS f32x2*)(T + w * 128 + 2 * lane); if (w < wave) { off0 += t.x; off1 += t.y; } tot0 += t.x; tot1 += t.y; }
    float kd0[8], kd1[8];
#pragma unroll
    for (int i = 0; i < 8; ++i) { kd0[i] = (1.0f - __expf(lf0[i])) * __expf(tot0 - (off0 + p0[i])); kd1[i] = (1.0f - __expf(lf1[i])) * __expf(tot1 - (off1 + p1[i])); }
    { u32x4 w0 = {pk2(kd0[0], kd0[1]), pk2(kd0[2], kd0[3]), pk2(kd0[4], kd0[5]), pk2(kd0[6], kd0[7])}, w1 = {pk2(kd1[0], kd1[1]), pk2(kd1[2], kd1[3]), pk2(kd1[4], kd1[5]), pk2(kd1[6], kd1[7])};
      *(LAS u32x4*)(lds + HG_KD + (2 * lane) * 144 + 16 * wave) = w0; *(LAS u32x4*)(lds + HG_KD + (2 * lane + 1) * 144 + 16 * wave) = w1; }
    { u32x4 w0, w1;
      w0.x = (vw[0] & 0xffffu) | (vw[1] << 16); w0.y = (vw[2] & 0xffffu) | (vw[3] << 16); w0.z = (vw[4] & 0xffffu) | (vw[5] << 16); w0.w = (vw[6] & 0xffffu) | (vw[7] << 16);
      w1.x = (vw[0] >> 16) | (vw[1] & 0xffff0000u); w1.y = (vw[2] >> 16) | (vw[3] & 0xffff0000u); w1.z = (vw[4] >> 16) | (vw[5] & 0xffff0000u); w1.w = (vw[6] >> 16) | (vw[7] & 0xffff0000u);
      *(LAS u32x4*)(lds + HG_VT + (2 * lane) * 144 + 16 * wave) = w0; *(LAS u32x4*)(lds + HG_VT + (2 * lane + 1) * 144 + 16 * wave) = w1; }
    if (wave == 0) *(f32x2*)(DEC + (size_t)unit * 128 + 2 * lane) = (f32x2){__expf(tot0), __expf(tot1)};
    __syncthreads();
    f32x4 acc[8];
#pragma unroll
    for (int n = 0; n < 8; ++n) acc[n] = (f32x4){0.f, 0.f, 0.f, 0.f};
#pragma unroll
    for (int ks = 0; ks < 2; ++ks) { const bf16x8 af = *(const LAS bf16x8*)(lds + HG_KD + (16 * wave + fr) * 144 + ks * 64 + q * 16);
#pragma unroll
        for (int n = 0; n < 8; ++n) { const bf16x8 bfr = *(const LAS bf16x8*)(lds + HG_VT + (16 * n + fr) * 144 + ks * 64 + q * 16); acc[n] = __builtin_amdgcn_mfma_f32_16x16x32_bf16(af, bfr, acc[n], 0, 0, 0); } }
    bf16* kv = KVT + (size_t)unit * 16384 + 16 * wave + 4 * q;
#pragma unroll
    for (int n = 0; n < 8; ++n) { u32x2 w = {pk2(acc[n][0], acc[n][1]), pk2(acc[n][2], acc[n][3])}; *(u32x2*)(kv + (size_t)(16 * n + fr) * 128) = w; }
    __syncthreads();
}
__device__ __forceinline__ void hgrnB_scan(bf16* KVT, const float* DEC, int gtid, int nthreads) {
    for (int idx = gtid; idx < 16 * 128 * 64; idx += nthreads) {
        const int bh = idx >> 13, rem = idx & 8191, vv = rem >> 6, kp = rem & 63;
        unsigned* p = (unsigned*)(KVT + (size_t)bh * 64 * 16384 + (size_t)vv * 128 + 2 * kp);
        const float* d = DEC + (size_t)bh * 64 * 128 + 2 * kp;
        float s0 = 0.f, s1 = 0.f;
#pragma unroll 8
        for (int c = 0; c < 64; ++c) { const unsigned w = p[(size_t)c * 8192]; const f32x2 dd = *(const f32x2*)(d + c * 128); p[(size_t)c * 8192] = pk2(s0, s1); s0 = dd.x * s0 + bflo(w); s1 = dd.y * s1 + bfhi(w); }
    }
}
__device__ __forceinline__ void hgrnC_unit(const bf16* Z, const bf16* SPT, const float* ng, bf16* YMIX, LAS unsigned char* lds, int unit, int wave, int lane) {
    const int bh = unit >> 6, c = unit & 63, b = bh >> 2, h = bh & 3, fr = lane & 15, q = lane >> 4, ti = wave >> 1, nh = wave & 1;
    bf16x8 sf[4][4];
    { const bf16* sp = SPT + (size_t)unit * 16384 + (size_t)(64 * nh + fr) * 128 + 8 * q;
#pragma unroll
      for (int n = 0; n < 4; ++n)
#pragma unroll
          for (int ks = 0; ks < 4; ++ks) sf[n][ks] = *(const bf16x8*)(sp + n * 16 * 128 + ks * 32); }
    const size_t rowc = (size_t)b * SEQ + c * 64;
    const bf16* zp = Z + (rowc + 8 * wave) * NIN + h * 128 + 2 * lane;
    float q0[8], q1[8], lf0[8], lf1[8]; unsigned vw[8];
#pragma unroll
    for (int i = 0; i < 8; ++i) { const unsigned wq = *(const unsigned*)(zp + (size_t)i * NIN), w = *(const unsigned*)(zp + (size_t)i * NIN + 512); q0[i] = bflo(wq); q1[i] = bfhi(wq); lf0[i] = bflo(w); lf1[i] = bfhi(w); vw[i] = *(const unsigned*)(zp + (size_t)i * NIN + 1024); }
    float p0[8], p1[8]; { float r0 = 0.f, r1 = 0.f;
#pragma unroll
        for (int i = 0; i < 8; ++i) { r0 += lf0[i]; r1 += lf1[i]; p0[i] = r0; p1[i] = r1; } }
    LAS float* T = (LAS float*)(lds + HG_T);
    *(LAS f32x2*)(T + wave * 128 + 2 * lane) = (f32x2){p0[7], p1[7]};
    __syncthreads();
    float off0 = 0.f, off1 = 0.f, ro0 = 0.f, ro1 = 0.f; float cr0[5], cr1[5];
    { float a0 = 0.f, a1 = 0.f;
#pragma unroll
      for (int w = 0; w < 8; ++w) { if ((w & 1) == 0) { cr0[w >> 1] = a0; cr1[w >> 1] = a1; }
          const f32x2 t = *(const LAS f32x2*)(T + w * 128 + 2 * lane);
          if (w < wave) { off0 += t.x; off1 += t.y; } if (w < (wave & ~1)) { ro0 += t.x; ro1 += t.y; } a0 += t.x; a1 += t.y; }
      cr0[4] = a0; cr1[4] = a1; }
    const int own = wave >> 1;
#pragma unroll
    for (int i = 0; i < 8; ++i) {
        const int t = 8 * wave + i;
        const float br0 = (off0 - ro0) + p0[i], br1 = (off1 - ro1) + p1[i];
        *(LAS unsigned*)(lds + HG_QT + t * 272 + 4 * lane) = pk2(q0[i] * __expf(off0 + p0[i]), q1[i] * __expf(off1 + p1[i]));
        *(LAS unsigned*)(lds + HG_QH + t * 272 + 4 * lane) = pk2(q0[i] * __expf(br0), q1[i] * __expf(br1));
        const float k0 = 1.0f - __expf(lf0[i]), k1 = 1.0f - __expf(lf1[i]);
#pragma unroll
        for (int ip = 0; ip < 4; ++ip) { if (ip >= own) {
            const float e0 = fminf((cr0[ip] - ro0) - br0, 80.f), e1 = fminf((cr1[ip] - ro1) - br1, 80.f);
            *(LAS unsigned*)(lds + HG_KH + (8 * ip * (ip + 1) + t) * 272 + 4 * lane) = pk2(k0 * __expf(e0), k1 * __expf(e1)); } }
    }
    { u32x4 w0, w1;
      w0.x = (vw[0] & 0xffffu) | (vw[1] << 16); w0.y = (vw[2] & 0xffffu) | (vw[3] << 16); w0.z = (vw[4] & 0xffffu) | (vw[5] << 16); w0.w = (vw[6] & 0xffffu) | (vw[7] << 16);
      w1.x = (vw[0] >> 16) | (vw[1] & 0xffff0000u); w1.y = (vw[2] >> 16) | (vw[3] & 0xffff0000u); w1.z = (vw[4] >> 16) | (vw[5] & 0xffff0000u); w1.w = (vw[6] >> 16) | (vw[7] & 0xffff0000u);
      *(LAS u32x4*)(lds + HG_VT + (2 * lane) * 144 + 16 * wave) = w0; *(LAS u32x4*)(lds + HG_VT + (2 * lane + 1) * 144 + 16 * wave) = w1; }
    __syncthreads();
    f32x4 acc[4];
#pragma unroll
    for (int n = 0; n < 4; ++n) acc[n] = (f32x4){0.f, 0.f, 0.f, 0.f};
#pragma unroll
    for (int ks = 0; ks < 4; ++ks) { const bf16x8 qa = *(const LAS bf16x8*)(lds + HG_QT + (16 * ti + fr) * 272 + ks * 64 + q * 16);
#pragma unroll
        for (int n = 0; n < 4; ++n) acc[n] = __builtin_amdgcn_mfma_f32_16x16x32_bf16(qa, sf[n][ks], acc[n], 0, 0, 0); }
    bf16x8 qh[4];
#pragma unroll
    for (int ks = 0; ks < 4; ++ks) qh[ks] = *(const LAS bf16x8*)(lds + HG_QH + (16 * ti + fr) * 272 + ks * 64 + q * 16);
    unsigned P[4][2];
#pragma unroll
    for (int j = 0; j < 4; ++j) { P[j][0] = 0u; P[j][1] = 0u;
        if (j <= ti) { f32x4 st = (f32x4){0.f, 0.f, 0.f, 0.f};
#pragma unroll
            for (int ks = 0; ks < 4; ++ks) { const bf16x8 kf = *(const LAS bf16x8*)(lds + HG_KH + (8 * ti * (ti + 1) + 16 * j + fr) * 272 + ks * 64 + q * 16); st = __builtin_amdgcn_mfma_f32_16x16x32_bf16(kf, qh[ks], st, 0, 0, 0); }
            if (j == ti) {
#pragma unroll
                for (int r = 0; r < 4; ++r) st[r] = (4 * q + r <= fr) ? st[r] : 0.f; }
            P[j][0] = pk2(st[0], st[1]); P[j][1] = pk2(st[2], st[3]); } }
#pragma unroll
    for (int jp = 0; jp < 2; ++jp) { if (2 * jp <= ti) { const bf16x8 pa = mk_frag(P[2 * jp][0], P[2 * jp][1], P[2 * jp + 1][0], P[2 * jp + 1][1]);
#pragma unroll
        for (int n = 0; n < 4; ++n) { const int vv = 64 * nh + 16 * n + fr;
            const u32x2 lo = *(const LAS u32x2*)(lds + HG_VT + vv * 144 + (32 * jp + 4 * q) * 2), hi = *(const LAS u32x2*)(lds + HG_VT + vv * 144 + (32 * jp + 16 + 4 * q) * 2);
            acc[n] = __builtin_amdgcn_mfma_f32_16x16x32_bf16(pa, mk_frag(lo.x, lo.y, hi.x, hi.y), acc[n], 0, 0, 0); } } }
    LAS float* SS = (LAS float*)(lds + HG_SS);
    float ssq[4];
#pragma unroll
    for (int r = 0; r < 4; ++r) { float s = 0.f;
#pragma unroll
        for (int n = 0; n < 4; ++n) s += acc[n][r] * acc[n][r];
        s += __shfl_xor(s, 1); s += __shfl_xor(s, 2); s += __shfl_xor(s, 4); s += __shfl_xor(s, 8); ssq[r] = s; }
    if (fr == 0) {
#pragma unroll
        for (int r = 0; r < 4; ++r) SS[(16 * ti + 4 * q + r) * 2 + nh] = ssq[r]; }
    __syncthreads();
#pragma unroll
    for (int r = 0; r < 4; ++r) { const int t = 16 * ti + 4 * q + r; const float rstd = rsqrtf((SS[t * 2] + SS[t * 2 + 1]) * (1.0f / 128.0f) + EPS);
#pragma unroll
        for (int n = 0; n < 4; ++n) { const int col = h * 128 + 64 * nh + 16 * n + fr; const float gz = bf2f(Z[(rowc + t) * NIN + 1536 + col]);
            YMIX[(rowc + t) * DM + col] = (bf16)(pk2(acc[n][r] * rstd * ng[col] * gz, 0.f) & 0xffffu); } }
    __syncthreads();
}

constexpr int GM_WS = 0, GM_VT = 34816;
__device__ __forceinline__ void gmlp_unit(const Args& a, LAS unsigned char* lds, int unit, int tid, int wave, int lane) {
    const int g = unit & 3, bn = unit >> 2, fr = lane & 15, q = lane >> 4; const size_t r0 = (size_t)bn * 128;
    const bf16* Z = (const bf16*)(a.ws + WS_Z); bf16* YMIX = (bf16*)(a.ws + WS_YMIX);
    const f32x4* wsg = (const f32x4*)(a.in[I_GWS] + (size_t)g * 16384);
#pragma unroll
    for (int it = 0; it < 8; ++it) { const int idx = tid + 512 * it, t = idx >> 5, s = 4 * (idx & 31); f32x4 w = wsg[idx];
        w.x = (s <= t) ? w.x : 0.f; w.y = (s + 1 <= t) ? w.y : 0.f; w.z = (s + 2 <= t) ? w.z : 0.f; w.w = (s + 3 <= t) ? w.w : 0.f;
        *(LAS u32x2*)(lds + GM_WS + t * 272 + s * 2) = (u32x2){pk2(w.x, w.y), pk2(w.z, w.w)}; }
    for (int rr = 0; rr < 16; ++rr) { const int row = 16 * wave + rr;
        const u32x4 x = *(const u32x4*)(Z + (r0 + row) * NIN + 2560 + 8 * lane);
        float xv[8] = {bflo(x.x), bfhi(x.x), bflo(x.y), bfhi(x.y), bflo(x.z), bfhi(x.z), bflo(x.w), bfhi(x.w)};
        float s = 0.f, ss = 0.f;
#pragma unroll
        for (int j = 0; j < 8; ++j) { s += xv[j]; ss += xv[j] * xv[j]; }
        s = wave_sum(s); ss = wave_sum(ss);
        const float mu = s * (1.0f / 512.0f), rstd = rsqrtf(fmaxf(ss * (1.0f / 512.0f) - mu * mu, 0.f) + EPS);
        if ((lane >> 4) == g) { const int d0 = 8 * (lane & 15);
#pragma unroll
            for (int j = 0; j < 8; ++j) { const float val = (xv[j] - mu) * rstd * a.in[I_LNG][g * 128 + d0 + j] + a.in[I_LNB][g * 128 + d0 + j];
                *(LAS unsigned short*)(lds + GM_VT + (d0 + j) * 272 + row * 2) = (unsigned short)(pk2(val, 0.f) & 0xffffu); } }
    }
    __syncthreads();
    f32x4 acc[8];
#pragma unroll
    for (int n = 0; n < 8; ++n) acc[n] = (f32x4){0.f, 0.f, 0.f, 0.f};
    const int nks = (wave + 2) >> 1;
#pragma unroll
    for (int ks = 0; ks < 4; ++ks) { if (ks < nks) { const bf16x8 af = *(const LAS bf16x8*)(lds + GM_WS + (16 * wave + fr) * 272 + ks * 64 + q * 16);
#pragma unroll
        for (int n = 0; n < 8; ++n) { const bf16x8 bfr = *(const LAS bf16x8*)(lds + GM_VT + (16 * n + fr) * 272 + ks * 64 + q * 16); acc[n] = __builtin_amdgcn_mfma_f32_16x16x32_bf16(af, bfr, acc[n], 0, 0, 0); } } }
#pragma unroll
    for (int r = 0; r < 4; ++r) { const int t = 16 * wave + 4 * q + r; const float bsv = a.in[I_GBS][g * 128 + t]; float y[8]; float s = 0.f;
#pragma unroll
        for (int n = 0; n < 8; ++n) { const float u = bf2f(Z[(r0 + t) * NIN + 2048 + g * 128 + 16 * n + fr]); y[n] = u * (acc[n][r] + bsv); s += y[n] * y[n]; }
        s += __shfl_xor(s, 1); s += __shfl_xor(s, 2); s += __shfl_xor(s, 4); s += __shfl_xor(s, 8);
        const float rstd = rsqrtf(s * (1.0f / 128.0f) + EPS);
#pragma unroll
        for (int n = 0; n < 8; ++n) { const int d = 16 * n + fr; YMIX[(r0 + t) * DM + 512 + g * 128 + d] = (bf16)(pk2(y[n] * rstd * a.in[I_GNG][g * 128 + d], 0.f) & 0xffffu); } }
    __syncthreads();
}

__device__ __forceinline__ void moe_table(const Args& a, volatile LAS unsigned* MISC, int wave, int lane) {
    if (wave == 0) {
        unsigned* cntg = (unsigned*)(a.ws + WS_CTL) + CW_CNT;
        const int c = lane < 32 ? (int)__hip_atomic_load(cntg + 64 * lane, __ATOMIC_RELAXED, __HIP_MEMORY_SCOPE_AGENT) : 0;
        const int nb = (c + 255) >> 8; int incl = nb;
#pragma unroll
        for (int o = 1; o < 32; o <<= 1) { const int t = __shfl_up(incl, o); if (lane >= o) incl += t; }
        if (lane < 32) { MISC[MOE_TAB + lane] = (unsigned)c; MISC[MOE_TAB + 32 + lane] = (unsigned)(incl - nb); }
        if (lane == 31) MISC[MOE_TAB + 64] = (unsigned)incl;
    }
    __syncthreads();
}

__device__ __forceinline__ void p9_final(const Args& a, int vcu, int G, int wave, int lane) {
    const int gw = vcu * 8 + wave, NGW = G * 8;
    const float* mod = (const float*)(a.ws + WS_MOD);
    const float* xmid = (const float*)(a.ws + WS_XMID);
    const bf16* ys = (const bf16*)(a.ws + WS_YSLOT);
    for (int m = gw; m < MT; m += NGW) {
        const int b = m / SEQ;
        const f32x4* xr = (const f32x4*)(xmid + (size_t)m * DM) + lane;
        f32x4 v[4]; float ss = 0.f;
#pragma unroll
        for (int j = 0; j < 4; ++j) { const int c = 4 * lane + 256 * j; f32x4 y = (f32x4){0.f, 0.f, 0.f, 0.f};
#pragma unroll
            for (int k = 0; k < 4; ++k) { const u32x2 w = *((const u32x2*)(ys + ((size_t)m * 4 + k) * DM + c)); y += (f32x4){bflo(w.x), bfhi(w.x), bflo(w.y), bfhi(w.y)}; }
            const f32x4 g2 = *(const f32x4*)(mod + b * 6144 + 5120 + c);
            v[j] = xr[64 * j] + g2 * y; ss += (v[j].x * v[j].x + v[j].y * v[j].y) + (v[j].z * v[j].z + v[j].w * v[j].w); }
        const float rstd = rsqrtf(wave_sum(ss) * (1.0f / DM) + EPS);
        f32x4* orow = (f32x4*)(a.out + (size_t)m * DM) + lane;
#pragma unroll
        for (int j = 0; j < 4; ++j) { const f32x4 g = *(const f32x4*)(a.in[I_FG] + 4 * lane + 256 * j); orow[64 * j] = (v[j] * rstd) * g; }
    }
}

constexpr int NPH = 11;
__global__ void __launch_bounds__(512, 2) mk_fwd(Args a) {
    extern __shared__ __attribute__((aligned(16))) unsigned char lds_raw[];
    LAS unsigned char* lds = (LAS unsigned char*)lds_raw;
    volatile LAS unsigned* MISC = (volatile LAS unsigned*)(lds + LDSCTL_OFF);
    const int tid = threadIdx.x, lane = tid & 63, wave = __builtin_amdgcn_readfirstlane(tid >> 6);
    const int G = gridDim.x; const int bx = blockIdx.x; const int vcu = (G % 8 == 0) ? (bx % 8) * (G / 8) + bx / 8 : bx;
    for (int u = tid; u < (LDS_BYTES - LDSCTL_OFF) / 4; u += 512) MISC[u] = 0u;
    __syncthreads();
    unsigned* ctl = (unsigned*)(a.ws + WS_CTL);
    const int lo = a.ph_lo, hi = a.ph_hi;
    const bool multi = (hi - lo) > 1;
    XcdBarrier bar; bar.bar = ctl + CW_BAR; bar.x = 0; bar.st = nullptr;
    if (multi) bar = xcd_barrier_post(ctl + CW_BAR, MISC + MISC_BAR);
#ifndef PH_MASK
#define PH_MASK 0xFFFF
#endif
#define IN(k) (((PH_MASK >> (k)) & 1) && lo <= (k) && (k) < hi)
#define SEAM(k) do { if (IN(k) && IN((k) + 1)) xcd_barrier(bar); } while (0)
    unsigned char* ws = a.ws;

    if (IN(0)) { p0_prologue(a, lds, vcu, G, tid, wave, lane); } SEAM(0);
    if (IN(1)) { p1_h1(a, vcu, G, wave, lane); } SEAM(1);
    if (IN(2)) {
        pg8::DenseSched S; S.init((const bf16*)(ws + WS_H), (const bf16*)(ws + WS_WIN), MT, NIN, DM, G, bx);
        EpiZ E{(bf16*)(ws + WS_Z), (const float*)(ws + WS_LB)};
        pg8::gemm_phase<EpiZ, pg8::DenseSched>(lds, S, E);
    } SEAM(2);
    if (IN(3)) {
        for (int it = bx; it < 1536; it += G) { if (it < 1024) hgrnA_unit((const bf16*)(ws + WS_Z), (bf16*)(ws + WS_KV), (float*)(ws + WS_DEC), lds, it, wave, lane); else gmlp_unit(a, lds, it - 1024, tid, wave, lane); }
    } SEAM(3);
    if (IN(4)) { hgrnB_scan((bf16*)(ws + WS_KV), (const float*)(ws + WS_DEC), bx * 512 + tid, G * 512); } SEAM(4);
    if (IN(5)) {
        for (int it = bx; it < 1024; it += G) hgrnC_unit((const bf16*)(ws + WS_Z), (const bf16*)(ws + WS_KV), a.in[I_HNG], (bf16*)(ws + WS_YMIX), lds, it, wave, lane);
    } SEAM(5);
    if (IN(6)) {
        pg8::DenseSched S; S.init((const bf16*)(ws + WS_YMIX), (const bf16*)(ws + WS_WOUT), MT, DM, DM, G, bx);
        EpiXmid E{a.in[I_X], (float*)(ws + WS_XMID), (const float*)(ws + WS_MOD)};
        pg8::gemm_phase<EpiXmid, pg8::DenseSched>(lds, S, E);
    } SEAM(6);
    if (IN(7)) { p6_router(a, lds, vcu, G, tid, wave, lane); } SEAM(7);
    if (IN(8)) {
        moe_table(a, MISC, wave, lane);
        pg8::MoeSched<true> S; S.A = (const bf16*)(ws + WS_H); S.W = (const bf16*)(ws + WS_WGU); S.K = DM; S.NT = 8; S.lists = (const int*)(ws + WS_LISTS);
        S.tab = (const LAS int*)(MISC + MOE_TAB); S.G = G; S.c = bx; S.U = (int)MISC[MOE_TAB + 64] * 8;
        EpiAct E{(bf16*)(ws + WS_ACT), a.in[I_BGU]};
        pg8::gemm_phase<EpiAct, pg8::MoeSched<true>>(lds, S, E);
    } SEAM(8);
    if (IN(9)) {
        moe_table(a, MISC, wave, lane);
        pg8::MoeSched<false> S; S.A = (const bf16*)(ws + WS_ACT); S.W = (const bf16*)(ws + WS_WD); S.K = DFF; S.NT = 4; S.lists = (const int*)(ws + WS_LISTS);
        S.tab = (const LAS int*)(MISC + MOE_TAB); S.G = G; S.c = bx; S.U = (int)MISC[MOE_TAB + 64] * 4;
        EpiDown E{(bf16*)(ws + WS_YSLOT), a.in[I_BD], (const float*)(ws + WS_GATES), (const int*)(ws + WS_LISTS)};
        pg8::gemm_phase<EpiDown, pg8::MoeSched<false>>(lds, S, E);
    } SEAM(9);
    if (IN(10)) { p9_final(a, vcu, G, wave, lane); }
#undef IN
#undef SEAM
}

__global__ void __launch_bounds__(128) k_hgrn_naive(const bf16* __restrict__ Z, float* __restrict__ OH) {
    __shared__ float sf[128], sq[128];
    const int bh = blockIdx.x, b = bh >> 2, h = bh & 3, v = threadIdx.x;
    float S[128];
#pragma unroll
    for (int k = 0; k < 128; ++k) S[k] = 0.f;
    for (int t = 0; t < SEQ; ++t) {
        const bf16* zr = Z + (size_t)(b * SEQ + t) * NIN;
        sf[v] = __expf(bf2f(zr[512 + h * 128 + v])); sq[v] = bf2f(zr[h * 128 + v]);
        const float vt = bf2f(zr[1024 + h * 128 + v]);
        __syncthreads();
        float o = 0.f;
#pragma unroll
        for (int k = 0; k < 128; ++k) { const float f = sf[k]; S[k] = f * S[k] + (1.0f - f) * vt; o += S[k] * sq[k]; }
        OH[(size_t)(b * SEQ + t) * HW + h * 128 + v] = o;
        __syncthreads();
    }
}
__global__ void __launch_bounds__(256) k_hgrn_out(const float* __restrict__ OH, const bf16* __restrict__ Z, const float* __restrict__ ng, bf16* __restrict__ YMIX) {
    const int wv = (blockIdx.x * 256 + threadIdx.x) >> 6, lane = threadIdx.x & 63; if (wv >= MT * NH) return;
    const int row = wv >> 2, h = wv & 3;
    const float o0 = OH[(size_t)row * HW + h * 128 + lane], o1 = OH[(size_t)row * HW + h * 128 + 64 + lane];
    const float rstd = rsqrtf(wave_sum(o0 * o0 + o1 * o1) * (1.0f / 128.0f) + EPS);
    const float g0 = bf2f(Z[(size_t)row * NIN + 1536 + h * 128 + lane]), g1 = bf2f(Z[(size_t)row * NIN + 1536 + h * 128 + 64 + lane]);
    const float y0 = o0 * rstd * ng[h * 128 + lane] * g0, y1 = o1 * rstd * ng[h * 128 + 64 + lane] * g1;
    YMIX[(size_t)row * DM + h * 128 + lane] = (bf16)(pk2(y0, 0.f) & 0xffffu); YMIX[(size_t)row * DM + h * 128 + 64 + lane] = (bf16)(pk2(y1, 0.f) & 0xffffu);
}
__global__ void __launch_bounds__(256) k_gmlp_ln(const bf16* __restrict__ Z, const float* __restrict__ lg, const float* __restrict__ lbias, float* __restrict__ VLN) {
    const int row = (blockIdx.x * 256 + threadIdx.x) >> 6, lane = threadIdx.x & 63; if (row >= MT) return;
    float x[8]; float s = 0.f;
#pragma unroll
    for (int j = 0; j < 8; ++j) { x[j] = bf2f(Z[(size_t)row * NIN + 2560 + lane + 64 * j]); s += x[j]; }
    const float mu = wave_sum(s) * (1.0f / 512.0f); float q = 0.f;
#pragma unroll
    for (int j = 0; j < 8; ++j) { x[j] -= mu; q += x[j] * x[j]; }
    const float rstd = rsqrtf(wave_sum(q) * (1.0f / 512.0f) + EPS);
#pragma unroll
    for (int j = 0; j < 8; ++j) VLN[(size_t)row * GW + lane + 64 * j] = x[j] * rstd * lg[lane + 64 * j] + lbias[lane + 64 * j];
}
__global__ void __launch_bounds__(256) k_gmlp_sv(const float* __restrict__ VLN, const bf16* __restrict__ Z, const float* __restrict__ gws, const float* __restrict__ gbs, float* __restrict__ YG) {
    const int idx = blockIdx.x * 256 + threadIdx.x; if (idx >= MT * GW) return;
    const int row = idx >> 9, ch = idx & 511, g = ch >> 7, tt = row & 127, base = row & ~127;
    const float* wr = gws + ((size_t)g * 128 + tt) * 128; float s = gbs[g * 128 + tt];
    for (int sidx = 0; sidx <= tt; ++sidx) s += wr[sidx] * VLN[(size_t)(base + sidx) * GW + ch];
    YG[idx] = bf2f(Z[(size_t)row * NIN + 2048 + ch]) * s;
}
__global__ void __launch_bounds__(256) k_gmlp_out(const float* __restrict__ YG, const float* __restrict__ ng, bf16* __restrict__ YMIX) {
    const int wv = (blockIdx.x * 256 + threadIdx.x) >> 6, lane = threadIdx.x & 63; if (wv >= MT * GG) return;
    const int row = wv >> 2, g = wv & 3;
    const float o0 = YG[(size_t)row * GW + g * 128 + lane], o1 = YG[(size_t)row * GW + g * 128 + 64 + lane];
    const float rstd = rsqrtf(wave_sum(o0 * o0 + o1 * o1) * (1.0f / 128.0f) + EPS);
    YMIX[(size_t)row * DM + 512 + g * 128 + lane] = (bf16)(pk2(o0 * rstd * ng[g * 128 + lane], 0.f) & 0xffffu);
    YMIX[(size_t)row * DM + 512 + g * 128 + 64 + lane] = (bf16)(pk2(o1 * rstd * ng[g * 128 + 64 + lane], 0.f) & 0xffffu);
}

extern "C" void kernel_launch(void* const* d_in, const int* in_sizes, int n_in, void* d_out, int out_size, void* d_ws, size_t ws_size, hipStream_t stream) {
    static int grid = 0;
    if (grid == 0) {
        if (n_in != 22 || in_sizes[0] != MT * DM || out_size != MT * DM || ws_size < WS_END) { fprintf(stderr, "kernel_launch: unexpected shapes (n_in %d, in0 %d, out %d, ws %zu)\n", n_in, n_in > 0 ? in_sizes[0] : -1, out_size, ws_size); grid = -1; return; }
        int dev = 0, cus = 0, per_cu = 0;
        if (hipGetDevice(&dev) != hipSuccess || hipDeviceGetAttribute(&cus, hipDeviceAttributeMultiprocessorCount, dev) != hipSuccess) { grid = -1; return; }
        if (hipFuncSetAttribute((const void*)mk_fwd, hipFuncAttributeMaxDynamicSharedMemorySize, LDS_BYTES) != hipSuccess) { fprintf(stderr, "kernel_launch: hipFuncSetAttribute failed\n"); grid = -1; return; }
        if (hipOccupancyMaxActiveBlocksPerMultiprocessor(&per_cu, (const void*)mk_fwd, 512, LDS_BYTES) != hipSuccess || per_cu < 1) fprintf(stderr, "kernel_launch: occupancy query says %d\n", per_cu);
        (void)hipGetLastError();
        grid = cus;
    }
    if (grid < 0) return;
    (void)hipMemsetAsync((char*)d_ws + WS_CTL, 0, CTL_ZERO_BYTES, stream);
    Args a{};
    for (int i = 0; i < 22; ++i) a.in[i] = (const float*)d_in[i];
    a.out = (float*)d_out; a.ws = (unsigned char*)d_ws;
    unsigned char* ws = (unsigned char*)d_ws;
    auto run = [&](int lo, int hi) { a.ph_lo = lo; a.ph_hi = hi; hipLaunchKernelGGL(mk_fwd, dim3(grid), dim3(512), LDS_BYTES, stream, a); };
#if defined(NAIVE_MIX)
    run(0, 1); run(1, 2); run(2, 3);
    hipLaunchKernelGGL(k_hgrn_naive, dim3(16), dim3(128), 0, stream, (const bf16*)(ws + WS_Z), (float*)(ws + WS_OH));
    hipLaunchKernelGGL(k_hgrn_out, dim3(MT * NH / 4), dim3(256), 0, stream, (const float*)(ws + WS_OH), (const bf16*)(ws + WS_Z), (const float*)d_in[I_HNG], (bf16*)(ws + WS_YMIX));
    hipLaunchKernelGGL(k_gmlp_ln, dim3(MT / 4), dim3(256), 0, stream, (const bf16*)(ws + WS_Z), (const float*)d_in[I_LNG], (const float*)d_in[I_LNB], (float*)(ws + WS_VLN));
    hipLaunchKernelGGL(k_gmlp_sv, dim3(MT * GW / 256), dim3(256), 0, stream, (const float*)(ws + WS_VLN), (const bf16*)(ws + WS_Z), (const float*)d_in[I_GWS], (const float*)d_in[I_GBS], (float*)(ws + WS_YG));
    hipLaunchKernelGGL(k_gmlp_out, dim3(MT * GG / 4), dim3(256), 0, stream, (const float*)(ws + WS_YG), (const float*)d_in[I_GNG], (bf16*)(ws + WS_YMIX));
    run(6, 7); run(7, 8); run(8, 9); run(9, 10); run(10, 11);
#else
    run(0, NPH);
#endif
}
```

```cpp
#include <hip/hip_runtime.h>
#include <cstdio>
#include <cstdint>

#define GAS __attribute__((address_space(1)))
#define LAS __attribute__((address_space(3)))
typedef unsigned short bf16;
typedef unsigned u32x4 __attribute__((ext_vector_type(4)));
typedef unsigned u32x2 __attribute__((ext_vector_type(2)));
typedef float f32x4 __attribute__((ext_vector_type(4)));
typedef float f32x2 __attribute__((ext_vector_type(2)));
typedef short bf16x8 __attribute__((ext_vector_type(8)));
typedef __bf16 bf16x2_t __attribute__((ext_vector_type(2)));

constexpr int DM = 1024, NB = 4, SEQ = 4096, MT = NB * SEQ;
constexpr int HW = 512, NH = 4, HD = 128, HCH = 64;
constexpr int GW = 512, GG = 4, GD = 128, GCH = 128;
constexpr int NIN = 3072, NE = 32, TOPK = 4, DFF = 1024;
constexpr int NSLOT = MT * TOPK;
constexpr int LSTRIDE = MT;
constexpr float EPS = 1e-6f;
constexpr float SW_LIMIT = 7.0f, SW_ALPHA = 1.702f;
constexpr float YS_SCALE = 8.0f;

constexpr size_t MiB = 1u << 20;
constexpr size_t WS_CTL = 0, CTL_ZERO_BYTES = 64 * 1024;
constexpr size_t WS_MOD = 1 * MiB;
constexpr size_t WS_LB = 1 * MiB + 128 * 1024;
constexpr size_t WS_WRH = 1 * MiB + 256 * 1024;
constexpr size_t WS_WRL = 1 * MiB + 384 * 1024;
constexpr size_t WS_WIN = 2 * MiB;
constexpr size_t WS_WOUT = 8 * MiB;
constexpr size_t WS_WGU = 16 * MiB;
constexpr size_t WS_WD = 144 * MiB;
constexpr size_t WS_H = 208 * MiB;
constexpr size_t WS_Z = 240 * MiB;
constexpr size_t WS_YMIX = 336 * MiB;
constexpr size_t WS_XMID = 368 * MiB;
constexpr size_t WS_KV = 432 * MiB;
constexpr size_t WS_DEC = 496 * MiB;
constexpr size_t WS_GATES = 497 * MiB;
constexpr size_t WS_LISTS = 498 * MiB;
constexpr size_t WS_LGATE = 502 * MiB;
constexpr size_t WS_ACT = 512 * MiB;
constexpr size_t WS_YSLOT = 656 * MiB;
constexpr size_t WS_OH = 784 * MiB;
constexpr size_t WS_VLN = 816 * MiB;
constexpr size_t WS_YG = 848 * MiB;
constexpr size_t WS_END = 880 * MiB;
constexpr int CW_TMO = 0, CW_CODE = 1, CW_MODRDY = 64;
constexpr int CW_BAR = 1024;
constexpr int CW_CNT = 8192, CNT_STRIDE = 64;
static_assert((CW_CNT + CNT_STRIDE * 32) * 4 <= (int)CTL_ZERO_BYTES, "ctl");

constexpr int LDS_BYTES = 163840;
constexpr int LDSCTL_OFF = 162816;
constexpr int MISC_BAR = 8;
constexpr int MOE_TAB = 64;
constexpr int AUX_OFF = 131072;

__device__ __forceinline__ float bf2f(unsigned short b) { return __uint_as_float(((unsigned)b) << 16); }
__device__ __forceinline__ unsigned pk2(float lo, float hi) { f32x2 v = {lo, hi}; bf16x2_t b = __builtin_convertvector(v, bf16x2_t); return __builtin_bit_cast(unsigned, b); }
__device__ __forceinline__ float bflo(unsigned w) { return __uint_as_float(w << 16); }
__device__ __forceinline__ float bfhi(unsigned w) { return __uint_as_float(w & 0xffff0000u); }
__device__ __forceinline__ float wave_sum(float v) {
#pragma unroll
    for (int o = 1; o < 64; o <<= 1) v += __shfl_xor(v, o);
    return v;
}
__device__ __forceinline__ void lds_barrier() { asm volatile("s_waitcnt lgkmcnt(0)" ::: "memory"); __builtin_amdgcn_s_barrier(); asm volatile("" ::: "memory"); }
__device__ __forceinline__ float fsigmoid(float z) { return __builtin_amdgcn_rcpf(1.0f + __builtin_amdgcn_exp2f(z * -1.4426950408889634f)); }
__device__ __forceinline__ f32x2 gelu_pk(f32x2 v) {
    const f32x2 av = __builtin_elementwise_abs(v), d = av * 0.2316418882f + 1.0f;
    f32x2 t; t.x = __builtin_amdgcn_rcpf(d.x); t.y = __builtin_amdgcn_rcpf(d.y);
    f32x2 q = t * 0.5307027145f + (-0.7265760135f); q = q * t + 0.7107068705f; q = q * t + (-0.142248368f); q = q * t + 0.127414796f; q = q * t;
    const f32x2 s = (v * v) * (-0.72134752044f);
    f32x2 e; e.x = __builtin_amdgcn_exp2f(s.x); e.y = __builtin_amdgcn_exp2f(s.y);
    const f32x2 m = v * (q * e), r = v - m;
    f32x2 o; o.x = v.x < 0.f ? m.x : r.x; o.y = v.y < 0.f ? m.y : r.y; return o;
}
__device__ __forceinline__ bf16x8 mk_frag(unsigned a, unsigned b, unsigned c, unsigned d) { u32x4 w = {a, b, c, d}; return __builtin_bit_cast(bf16x8, w); }
__device__ __forceinline__ float gelu1(float x) { f32x2 r = gelu_pk((f32x2){x, x}); return r.x; }

namespace pg8 {
constexpr int BM = 256, BK = 64, HALF = 128, HTB = HALF * BK * 2, STAGE_BYTES = 8 * HTB, NXCD = 8, WGM = 8;
__host__ __device__ __forceinline__ int lds_byte(int r, int c) { const int st = (r >> 4) * 2 + (c >> 5), rr = r & 15, cc = c & 31, ob = rr * 64 + cc * 2; return st * 1024 + (ob ^ (((ob >> 9) & 1) << 5)); }
__host__ __device__ __forceinline__ void stage_rc(int b, int& R, int& C) { const int st = b / 1024, sb = b % 1024, swz = sb ^ (((sb >> 9) & 1) << 5); R = (st >> 1) * 16 + swz / 64; C = (st & 1) * 32 + (swz % 64) / 2; }
__host__ __device__ __forceinline__ int perm32(int rho) { const int n = rho >> 4, i = rho & 15; return 8 * (i >> 2) + 4 * n + (i & 3); }

struct Unit { int pm, pn, e, rb, cnt; };

struct DenseSched {
    static constexpr bool GATHER = false;
    const bf16* A; const bf16* Bt; int K;
    int nM, nN, nwg, G, c;
    __device__ void init(const bf16* A_, const bf16* Bt_, int M, int N, int K_, int G_, int c_) { A = A_; Bt = Bt_; K = K_; nM = M / BM; nN = N / BM; nwg = nM * nN; G = G_; c = c_; }
    __device__ __forceinline__ bool next(int i, Unit& u) const {
        const long L = (long)i * G + c; if (L >= nwg) return false;
        int wgid = (int)L; { const int q = nwg / NXCD, r = nwg % NXCD, xcd = wgid % NXCD, off = wgid / NXCD; wgid = (xcd < r ? xcd * (q + 1) : r * (q + 1) + (xcd - r) * q) + off; }
        const int nig = WGM * nN, gid = wgid / nig, fm = gid * WGM, gsz = (nM - fm) < WGM ? (nM - fm) : WGM;
        u.pm = fm + ((wgid % nig) % gsz); u.pn = (wgid % nig) / gsz; u.e = 0; u.rb = 0; u.cnt = 256; return true;
    }
    __device__ __forceinline__ const char* a_ptr(const Unit& u) const { return (const char*)A + (size_t)u.pm * (size_t)(2 * HALF) * K * 2; }
    __device__ __forceinline__ const char* b_ptr(const Unit& u) const { return (const char*)Bt + (size_t)u.pn * (size_t)(2 * HALF) * K * 2; }
    __device__ __forceinline__ void gather_off(const Unit&, int, const LAS unsigned char*, int, unsigned (&)[2][2]) const {}
    __device__ __forceinline__ void prefetch_rows(LAS unsigned char*, int) const {}
};
template <bool GATH> struct MoeSched {
    static constexpr bool GATHER = GATH;
    const bf16* A; const bf16* W; int K; int NT;
    const int* lists; const LAS int* tab; int G, c, U;
    __device__ __forceinline__ bool next(int i, Unit& u) const {
        const long L = (long)i * G + c; if (L >= U) return false;
        int wgid = (int)L; { const int q = U / NXCD, r = U % NXCD, xcd = wgid % NXCD, off = wgid / NXCD; wgid = (xcd < r ? xcd * (q + 1) : r * (q + 1) + (xcd - r) * q) + off; }
        const int ln = threadIdx.x & 63; const int pre = tab[32 + (ln & 31)] * NT;
        const unsigned long long mk = __ballot(ln < 32 && pre <= wgid);
        const int e = 63 - __builtin_clzll(mk | 1ull);
        const int rb0 = tab[32 + e], nb = tab[32 + e + 1] - rb0, j = wgid - rb0 * NT;
        u.e = e; u.pn = j / nb; u.rb = j % nb; u.pm = rb0 + u.rb; u.cnt = tab[e] - u.rb * 256; return true;
    }
    __device__ __forceinline__ const char* a_ptr(const Unit& u) const { return GATH ? (const char*)A : (const char*)A + (size_t)u.pm * (size_t)(2 * HALF) * K * 2; }
    __device__ __forceinline__ const char* b_ptr(const Unit& u) const { return (const char*)W + ((size_t)u.e * NT + u.pn) * (size_t)(2 * HALF) * K * 2; }
    __device__ __forceinline__ void prefetch_rows(LAS unsigned char* auxr, int tid) const {
        int tmp[9]; Unit u;
#pragma unroll
        for (int i = 0; i < 9; ++i) { tmp[i] = 0; if (tid < 256 && next(i, u)) { const int rc = tid < u.cnt ? tid : u.cnt - 1; tmp[i] = lists[(size_t)u.e * LSTRIDE + u.rb * 256 + rc] >> 2; } }
        if (tid < 256) {
#pragma unroll
            for (int i = 0; i < 9; ++i) ((LAS int*)auxr)[i * 256 + tid] = tmp[i]; }
    }
    __device__ __forceinline__ void gather_off(const Unit& u, int ui, const LAS unsigned char* auxr, int tid, unsigned (&v)[2][2]) const {
#pragma unroll
        for (int i = 0; i < 2; ++i) { int R, C; stage_rc(tid * 16 + i * 8192, R, C);
#pragma unroll
            for (int h = 0; h < 2; ++h) { const int tok = ((const LAS int*)auxr)[ui * 256 + R + 128 * h]; v[h][i] = (unsigned)tok * (unsigned)(K * 2) + (unsigned)(C * 2); } }
    }
};

template <class Epi, class Sched>
__device__ __forceinline__ void gemm_phase(LAS unsigned char* lds, const Sched& S, const Epi& E) {
    const int tid = threadIdx.x, wid = __builtin_amdgcn_readfirstlane(tid >> 6), lane = tid & 63, wr = wid >> 2, wc = wid & 3, fr = lane & 15, fq = lane >> 4;
    const int K = S.K, nt = K / BK;
    unsigned voffA[2], voffB[2];
#pragma unroll
    for (int i = 0; i < 2; ++i) { int R, C; stage_rc(tid * 16 + i * 8192, R, C); const int Rb = Epi::PERM ? ((R & ~31) + perm32(R & 31)) : R;
        voffA[i] = (unsigned)(R * K + C) * 2u; voffB[i] = (unsigned)(Rb * K + C) * 2u; }
    const size_t kstep = (size_t)(BK * 2);
    const size_t hstep = (size_t)HALF * K * 2;
    const unsigned ldsw = (unsigned)wid * 1024u;
    const int aoff = lds_byte(wr * 64 + fr, fq * 8), boff = lds_byte(wc * 32 + fr, fq * 8);
#define PG8_SA(b, h) (((b) * 2 + (h)) * HTB)
#define PG8_SB(b, h) ((4 + (b) * 2 + (h)) * HTB)
#define PG8_GLDS(gp, off) __builtin_amdgcn_global_load_lds((const unsigned*)(gp), (LAS unsigned*)(lds + (off)), 16, 0, 0)
#define PG8_STAGE_B(bufoff, gbase) do { _Pragma("unroll") for (int _i = 0; _i < 2; ++_i) PG8_GLDS((const char*)(gbase) + voffB[_i], (bufoff) + ldsw + _i * 8192); } while (0)
#define PG8_STAGE_A(bufoff, h, kp) do { if constexpr (Sched::GATHER) { _Pragma("unroll") for (int _i = 0; _i < 2; ++_i) PG8_GLDS((const char*)(kp) + vAc[h][_i], (bufoff) + ldsw + _i * 8192); } \
        else { _Pragma("unroll") for (int _i = 0; _i < 2; ++_i) PG8_GLDS((const char*)(kp) + (h) * hstep + voffA[_i], (bufoff) + ldsw + _i * 8192); } } while (0)
#define PG8_LDA(dst, b, h) do { _Pragma("unroll") for (int m = 0; m < 4; ++m) _Pragma("unroll") for (int k = 0; k < 2; ++k) dst[m][k] = *(const LAS bf16x8*)(lds + PG8_SA(b, h) + aoff + m * 2048 + k * 1024); } while (0)
#define PG8_LDB(dst, b, h) do { _Pragma("unroll") for (int n = 0; n < 2; ++n) _Pragma("unroll") for (int k = 0; k < 2; ++k) dst[n][k] = *(const LAS bf16x8*)(lds + PG8_SB(b, h) + boff + n * 2048 + k * 1024); } while (0)
#define PG8_MMA(ai, bj, At, Bt) do { __builtin_amdgcn_s_setprio(1); _Pragma("unroll") for (int m = 0; m < 4; ++m) _Pragma("unroll") for (int n = 0; n < 2; ++n) _Pragma("unroll") for (int k = 0; k < 2; ++k) \
        acc[ai][bj][m][n] = __builtin_amdgcn_mfma_f32_16x16x32_bf16(Bt[n][k], At[m][k], acc[ai][bj][m][n], 0, 0, 0); __builtin_amdgcn_s_setprio(0); } while (0)
#define PG8_WAIT_V(n) asm volatile("s_waitcnt vmcnt(" #n ")" ::: "memory")
#define PG8_WAIT_L(n) asm volatile("s_waitcnt lgkmcnt(" #n ")" ::: "memory")
#define PG8_BAR __builtin_amdgcn_s_barrier()
#define PG8_SCHED __builtin_amdgcn_sched_barrier(0)
    Unit cur, nxt; int ui = 0;
    if constexpr (Sched::GATHER) S.prefetch_rows(lds + AUX_OFF + 16384, tid);
    if constexpr (Epi::LDSPRE || Sched::GATHER) { if constexpr (Epi::LDSPRE) E.prefetch(S, lds + AUX_OFF, tid); asm volatile("s_waitcnt lgkmcnt(0)" ::: "memory"); __builtin_amdgcn_s_barrier(); asm volatile("" ::: "memory"); }
    if (!S.next(0, cur)) return;
    f32x4 acc[2][2][4][2];
#pragma unroll
    for (int a = 0; a < 2; ++a)
#pragma unroll
        for (int b = 0; b < 2; ++b)
#pragma unroll
            for (int m = 0; m < 4; ++m)
#pragma unroll
                for (int n = 0; n < 2; ++n) acc[a][b][m][n] = (f32x4){0.f, 0.f, 0.f, 0.f};
    bf16x8 At[4][2], B0[2][2], B1[2][2];
    unsigned vAc[2][2] = {{0u, 0u}, {0u, 0u}};
    if constexpr (Sched::GATHER) { S.gather_off(cur, 0, lds + AUX_OFF + 16384, tid, vAc); }
    const char* cA = S.a_ptr(cur); const char* cB = S.b_ptr(cur);
    PG8_STAGE_B(PG8_SB(0, 0), cB); PG8_STAGE_B(PG8_SB(0, 1), cB + hstep); PG8_STAGE_A(PG8_SA(0, 0), 0, cA); PG8_STAGE_A(PG8_SA(0, 1), 1, cA);
    if (wr == 1) PG8_BAR;
    PG8_WAIT_V(2); PG8_BAR;
    PG8_STAGE_B(PG8_SB(1, 0), cB + kstep); PG8_STAGE_A(PG8_SA(1, 0), 0, cA + kstep); PG8_STAGE_B(PG8_SB(1, 1), cB + hstep + kstep);
    PG8_WAIT_V(6); PG8_BAR;
    for (;;) {
        const bool has_next = S.next(ui + 1, nxt);
        const char* nA = has_next ? S.a_ptr(nxt) : cA; const char* nB = has_next ? S.b_ptr(nxt) : cB;
        for (int t = 0; t < nt; t += 2) {
            const bool last = (t == nt - 2);
            const char* a1 = cA + (size_t)(t + 1) * kstep;
            const char* a2 = last ? nA : cA + (size_t)(t + 2) * kstep; const char* b2 = last ? nB : cB + (size_t)(t + 2) * kstep;
            const char* a3 = a2 + kstep; const char* b3 = b2 + kstep;
            PG8_LDB(B0, 0, 0); PG8_LDB(B1, 0, 1); PG8_SCHED; PG8_LDA(At, 0, 0); PG8_STAGE_A(PG8_SA(1, 1), 1, a1);
            if constexpr (Sched::GATHER) { if (last && has_next) S.gather_off(nxt, ui + 1, lds + AUX_OFF + 16384, tid, vAc); }
            PG8_WAIT_V(8); PG8_WAIT_L(0); PG8_BAR; PG8_MMA(0, 0, At, B0); PG8_MMA(0, 1, At, B1); PG8_BAR; PG8_SCHED;
            PG8_LDA(At, 0, 1); PG8_STAGE_B(PG8_SB(0, 0), b2); PG8_STAGE_B(PG8_SB(0, 1), b2 + hstep); PG8_STAGE_A(PG8_SA(0, 0), 0, a2);
            PG8_WAIT_V(8); PG8_WAIT_L(0); PG8_BAR; PG8_MMA(1, 0, At, B0); PG8_MMA(1, 1, At, B1); PG8_BAR; PG8_SCHED;
            PG8_LDB(B0, 1, 0); PG8_LDB(B1, 1, 1); PG8_SCHED; PG8_LDA(At, 1, 0); PG8_STAGE_A(PG8_SA(0, 1), 1, a2);
            PG8_WAIT_V(8); PG8_WAIT_L(0); PG8_BAR; PG8_MMA(0, 0, At, B0); PG8_MMA(0, 1, At, B1); PG8_BAR; PG8_SCHED;
            PG8_LDA(At, 1, 1); PG8_STAGE_B(PG8_SB(1, 0), b3); PG8_STAGE_B(PG8_SB(1, 1), b3 + hstep); PG8_STAGE_A(PG8_SA(1, 0), 0, a3);
            PG8_WAIT_V(8); PG8_WAIT_L(0); PG8_BAR; PG8_MMA(1, 0, At, B0); PG8_MMA(1, 1, At, B1); PG8_BAR; PG8_SCHED;
        }
        if (wr == 0) PG8_BAR;
        E(acc, cur, wr, wc, fr, fq, ui, lds + AUX_OFF);
        if (!has_next) break;
#pragma unroll
        for (int a = 0; a < 2; ++a)
#pragma unroll
            for (int b = 0; b < 2; ++b)
#pragma unroll
                for (int m = 0; m < 4; ++m)
#pragma unroll
                    for (int n = 0; n < 2; ++n) acc[a][b][m][n] = (f32x4){0.f, 0.f, 0.f, 0.f};
        cur = nxt; cA = nA; cB = nB; ++ui;
        if (wr == 1) PG8_BAR;
    }
    PG8_WAIT_V(0);
    PG8_BAR;
#undef PG8_SA
#undef PG8_SB
#undef PG8_GLDS
#undef PG8_STAGE_A
#undef PG8_STAGE_B
#undef PG8_LDA
#undef PG8_LDB
#undef PG8_MMA
#undef PG8_WAIT_V
#undef PG8_WAIT_L
#undef PG8_BAR
#undef PG8_SCHED
}
}

struct EpiZ {
    static constexpr bool PERM = true, LDSPRE = false;
    template <class Sched> __device__ __forceinline__ void prefetch(const Sched&, LAS unsigned char*, int) const {}
    bf16* Z; const float* lb;
    __device__ __forceinline__ void operator()(const f32x4 (&acc)[2][2][4][2], const pg8::Unit& u, int wr, int wc, int fr, int fq, int ui, const LAS unsigned char* aux) const {
        const int row0 = u.pm * 256 + wr * 64 + fr, seg = u.pn >> 1, col0 = u.pn * 256 + wc * 32 + 8 * fq;
        f32x4 lbv[2][2];
#pragma unroll
        for (int bj = 0; bj < 2; ++bj)
#pragma unroll
            for (int n = 0; n < 2; ++n) lbv[bj][n] = (seg == 1) ? *(const f32x4*)(lb + (col0 - 512) + bj * 128 + 4 * n) : (f32x4){0.f, 0.f, 0.f, 0.f};
#pragma unroll
        for (int ai = 0; ai < 2; ++ai)
#pragma unroll
            for (int m = 0; m < 4; ++m) { bf16* rowp = Z + (size_t)(row0 + ai * 128 + m * 16) * NIN + col0;
#pragma unroll
                for (int bj = 0; bj < 2; ++bj) { f32x4 v0 = acc[ai][bj][m][0], v1 = acc[ai][bj][m][1];
                    if (seg == 1) {
#pragma unroll
                        for (int j = 0; j < 4; ++j) { const float l0 = lbv[bj][0][j], l1 = lbv[bj][1][j];
                            v0[j] = __builtin_amdgcn_logf(l0 + (1.0f - l0) * fsigmoid(v0[j])); v1[j] = __builtin_amdgcn_logf(l1 + (1.0f - l1) * fsigmoid(v1[j])); }
                    } else if (seg == 3) {
#pragma unroll
                        for (int j = 0; j < 4; ++j) { v0[j] = v0[j] * fsigmoid(v0[j]); v1[j] = v1[j] * fsigmoid(v1[j]); }
                    } else if (seg >= 4) {
                        f32x2 a = gelu_pk((f32x2){v0[0], v0[1]}), b = gelu_pk((f32x2){v0[2], v0[3]}), c = gelu_pk((f32x2){v1[0], v1[1]}), d = gelu_pk((f32x2){v1[2], v1[3]});
                        v0 = (f32x4){a.x, a.y, b.x, b.y}; v1 = (f32x4){c.x, c.y, d.x, d.y};
                    }
                    u32x4 w; w.x = pk2(v0[0], v0[1]); w.y = pk2(v0[2], v0[3]); w.z = pk2(v1[0], v1[1]); w.w = pk2(v1[2], v1[3]);
                    *(u32x4*)(rowp + bj * 128) = w; } }
    }
};
struct EpiXmid {
    static constexpr bool PERM = true, LDSPRE = false;
    template <class Sched> __device__ __forceinline__ void prefetch(const Sched&, LAS unsigned char*, int) const {}
    const float* x; bf16* xmid; const float* mod;
    __device__ __forceinline__ void operator()(const f32x4 (&acc)[2][2][4][2], const pg8::Unit& u, int wr, int wc, int fr, int fq, int ui, const LAS unsigned char* aux) const {
        const int row0 = u.pm * 256 + wr * 64 + fr, col0 = u.pn * 256 + wc * 32 + 8 * fq, b = (u.pm * 256) / SEQ;
        f32x4 gv[2][2];
#pragma unroll
        for (int bj = 0; bj < 2; ++bj)
#pragma unroll
            for (int n = 0; n < 2; ++n) gv[bj][n] = *(const f32x4*)(mod + b * 6144 + 2048 + col0 + bj * 128 + 4 * n);
#pragma unroll
        for (int ai = 0; ai < 2; ++ai)
#pragma unroll
            for (int mp = 0; mp < 2; ++mp) {
                f32x4 xv[2][2][2];
#pragma unroll
                for (int mm = 0; mm < 2; ++mm) { const size_t off = (size_t)(row0 + ai * 128 + (2 * mp + mm) * 16) * DM + col0;
#pragma unroll
                    for (int bj = 0; bj < 2; ++bj)
#pragma unroll
                        for (int n = 0; n < 2; ++n) xv[mm][bj][n] = *(const f32x4*)(x + off + bj * 128 + 4 * n); }
#pragma unroll
                for (int mm = 0; mm < 2; ++mm) { const int m = 2 * mp + mm; const size_t off = (size_t)(row0 + ai * 128 + m * 16) * DM + col0;
#pragma unroll
                    for (int bj = 0; bj < 2; ++bj) { const f32x4 v0 = xv[mm][bj][0] + gv[bj][0] * acc[ai][bj][m][0], v1 = xv[mm][bj][1] + gv[bj][1] * acc[ai][bj][m][1];
                        u32x4 w; w.x = pk2(v0[0], v0[1]); w.y = pk2(v0[2], v0[3]); w.z = pk2(v1[0], v1[1]); w.w = pk2(v1[2], v1[3]);
                        *(u32x4*)(xmid + off + bj * 128) = w; } } }
    }
};

struct EpiAct {
    static constexpr bool PERM = true, LDSPRE = true;
    template <class Sched> __device__ __forceinline__ void prefetch(const Sched& S, LAS unsigned char* aux, int tid) const {
        float tmp[9]; pg8::Unit u;
#pragma unroll
        for (int i = 0; i < 9; ++i) { tmp[i] = 0.f; if (tid < 256 && S.next(i, u)) tmp[i] = bgu[(size_t)u.e * 2048 + (tid >> 7) * 1024 + u.pn * 128 + (tid & 127)]; }
        if (tid < 256) {
#pragma unroll
            for (int i = 0; i < 9; ++i) ((LAS float*)aux)[i * 256 + tid] = tmp[i]; }
    }
    bf16* act; const float* bgu;
    __device__ __forceinline__ void operator()(const f32x4 (&acc)[2][2][4][2], const pg8::Unit& u, int wr, int wc, int fr, int fq, int ui, const LAS unsigned char* aux) const {
        const int row0 = u.pm * 256 + wr * 64 + fr, c0 = u.pn * 128 + wc * 32 + 8 * fq;
        const LAS float* bg = (const LAS float*)aux + ui * 256 + wc * 32 + 8 * fq;
        f32x4 bgv[2], buv[2];
#pragma unroll
        for (int n = 0; n < 2; ++n) { bgv[n] = *(const LAS f32x4*)(bg + 4 * n); buv[n] = *(const LAS f32x4*)(bg + 128 + 4 * n); }
#pragma unroll
        for (int ai = 0; ai < 2; ++ai)
#pragma unroll
            for (int m = 0; m < 4; ++m) { bf16* rowp = act + (size_t)(row0 + ai * 128 + m * 16) * DFF + c0;
                float o[8];
#pragma unroll
                for (int n = 0; n < 2; ++n)
#pragma unroll
                    for (int j = 0; j < 4; ++j) { float g = acc[ai][0][m][n][j] + bgv[n][j], up = acc[ai][1][m][n][j] + buv[n][j];
                        g = fminf(g, SW_LIMIT); up = fminf(fmaxf(up, -SW_LIMIT), SW_LIMIT);
                        const float glu = g * __builtin_amdgcn_rcpf(1.0f + __builtin_amdgcn_exp2f(g * (-SW_ALPHA * 1.4426950408889634f))); o[4 * n + j] = fmaf(up, glu, glu); }
                u32x4 w; w.x = pk2(o[0], o[1]); w.y = pk2(o[2], o[3]); w.z = pk2(o[4], o[5]); w.w = pk2(o[6], o[7]);
                *(u32x4*)rowp = w; }
    }
};
struct EpiDown {
    static constexpr bool PERM = true, LDSPRE = true;
    template <class Sched> __device__ __forceinline__ void prefetch(const Sched& S, LAS unsigned char* aux, int tid) const {
        float tb[5]; int ts[5]; float tg[5]; pg8::Unit u;
#pragma unroll
        for (int i = 0; i < 5; ++i) { tb[i] = 0.f; ts[i] = 0; tg[i] = 0.f;
            if (S.next(i, u)) { if (tid < 256) tb[i] = bd[(size_t)u.e * DM + u.pn * 256 + tid];
                else { const int rl = tid - 256, rc = rl < u.cnt ? rl : u.cnt - 1; const size_t li = (size_t)u.e * LSTRIDE + u.rb * 256 + rc; ts[i] = lists[li]; tg[i] = lgate[li]; } } }
#pragma unroll
        for (int i = 0; i < 5; ++i) { if (tid < 256) ((LAS float*)aux)[i * 256 + tid] = tb[i]; else { ((LAS int*)(aux + 5120))[i * 256 + tid - 256] = ts[i]; ((LAS float*)(aux + 10240))[i * 256 + tid - 256] = tg[i]; } }
    }
    unsigned char* yslot; const float* bd; const float* lgate; const int* lists;
    __device__ __forceinline__ void operator()(const f32x4 (&acc)[2][2][4][2], const pg8::Unit& u, int wr, int wc, int fr, int fq, int ui, const LAS unsigned char* aux) const {
        const int rl0 = wr * 64 + fr, col0 = u.pn * 256 + wc * 32 + 8 * fq;
        f32x4 bv[2][2];
#pragma unroll
        for (int bj = 0; bj < 2; ++bj)
#pragma unroll
            for (int n = 0; n < 2; ++n) bv[bj][n] = *(const LAS f32x4*)((const LAS float*)aux + ui * 256 + bj * 128 + wc * 32 + 8 * fq + 4 * n);
        int slot[2][4]; float gwv[2][4];
#pragma unroll
        for (int ai = 0; ai < 2; ++ai)
#pragma unroll
            for (int m = 0; m < 4; ++m) { const int rl = rl0 + ai * 128 + m * 16; slot[ai][m] = ((const LAS int*)(aux + 5120))[ui * 256 + rl]; gwv[ai][m] = ((const LAS float*)(aux + 10240))[ui * 256 + rl]; }
#pragma unroll
        for (int ai = 0; ai < 2; ++ai)
#pragma unroll
            for (int m = 0; m < 4; ++m) { const int rl = rl0 + ai * 128 + m * 16;
                if (rl < u.cnt) { const float gw = gwv[ai][m] * YS_SCALE;
                    unsigned char* rowp = yslot + (size_t)slot[ai][m] * DM + col0;
#pragma unroll
                    for (int bj = 0; bj < 2; ++bj) { const f32x4 v0 = (acc[ai][bj][m][0] + bv[bj][0]) * gw, v1 = (acc[ai][bj][m][1] + bv[bj][1]) * gw;
                        int w0 = __builtin_amdgcn_cvt_pk_fp8_f32(v0[0], v0[1], 0, false); w0 = __builtin_amdgcn_cvt_pk_fp8_f32(v0[2], v0[3], w0, true);
                        int w1 = __builtin_amdgcn_cvt_pk_fp8_f32(v1[0], v1[1], 0, false); w1 = __builtin_amdgcn_cvt_pk_fp8_f32(v1[2], v1[3], w1, true);
                        *(u32x2*)(rowp + bj * 128) = (u32x2){(unsigned)w0, (unsigned)w1}; } } }
    }
};

#define XB_TMO      128
#define XB_XCNT(j)  (256  + 64 * (j))
#define XB_XSUB(j)  (1280 + 64 * (j))
#define XB_XGEN(j)  (2304 + 64 * (j))
#define XB_TOP      3328
#define XB_TOPGEN   3392
#define XCD_BAR_WORDS 3456
#define XB_SPIN_CAP (1u << 18)
__device__ __forceinline__ unsigned xb_ld(unsigned* p)              { return __hip_atomic_load(p, __ATOMIC_RELAXED, __HIP_MEMORY_SCOPE_AGENT); }
__device__ __forceinline__ unsigned xb_add(unsigned* p, unsigned v) { return __hip_atomic_fetch_add(p, v, __ATOMIC_RELAXED, __HIP_MEMORY_SCOPE_AGENT); }
__device__ __forceinline__ unsigned xb_xcc_id() { return (unsigned)__builtin_amdgcn_s_getreg((3 << 11) | 20) & 0xFu; }
#define XB_SPIN(cond, bar) do { unsigned _sp = 0; while (cond) { __builtin_amdgcn_s_sleep(1); \
    if ((++_sp & 255u) == 0u) { if (xb_ld(&(bar)[XB_TMO])) break; if (_sp > XB_SPIN_CAP) { atomicAdd(&(bar)[XB_TMO], 1u); break; } } } } while (0)
struct XcdBarrier { unsigned* bar; unsigned x; volatile LAS unsigned* st; };
__device__ __forceinline__ XcdBarrier xcd_barrier_post(unsigned* bar, volatile LAS unsigned* st) {
    XcdBarrier b; b.bar = bar; b.x = xb_xcc_id(); b.st = st;
    if (threadIdx.x == 0) (void)xb_add(&bar[XB_XCNT(b.x)], 1u);
    return b;
}
__device__ __forceinline__ void xcd_barrier_complete(unsigned* bar, unsigned x, unsigned& nloc, unsigned& nx) {
    const unsigned G = gridDim.x * gridDim.y * gridDim.z;
    unsigned sum, cnt, mine, sp = 0u;
    for (;;) {
        sum = 0u; cnt = 0u; mine = 0u;
#pragma unroll
        for (unsigned j = 0; j < 16; ++j) { const unsigned c = xb_ld(&bar[XB_XCNT(j)]); sum += c; cnt += (c > 0u) ? 1u : 0u; mine = (j == x) ? c : mine; }
        if (sum == G) break;
        __builtin_amdgcn_s_sleep(1);
        if ((++sp & 255u) == 0u) { if (xb_ld(&bar[XB_TMO])) break; if (sp > XB_SPIN_CAP) { atomicAdd(&bar[XB_TMO], 1u); break; } }
    }
    nloc = mine > 0u ? mine : 1u; nx = cnt > 0u ? cnt : 1u;
}
__device__ __forceinline__ void xcd_barrier(const XcdBarrier& b) {
    asm volatile("s_waitcnt vmcnt(0)" ::: "memory");
    __syncthreads();
    if (threadIdx.x == 0) {
        unsigned* bar = b.bar;
        __builtin_amdgcn_s_waitcnt(0);
        unsigned nloc = b.st[0], nx = b.st[1];
        if (nloc == 0u) { xcd_barrier_complete(bar, b.x, nloc, nx); b.st[0] = nloc; b.st[1] = nx; }
        const unsigned old = xb_add(&bar[XB_XSUB(b.x)], 1u);
        const unsigned gen = old / nloc;
        if (old + 1u == (gen + 1u) * nloc) {
            __builtin_amdgcn_fence(__ATOMIC_RELEASE, "agent");
            asm volatile("s_waitcnt vmcnt(0)" ::: "memory");
            const unsigned og = xb_add(&bar[XB_TOP], 1u);
            const unsigned tg = og / nx;
            if (og + 1u == (tg + 1u) * nx) xb_add(&bar[XB_TOPGEN], 1u);
            else XB_SPIN(xb_ld(&bar[XB_TOPGEN]) == tg, bar);
            __builtin_amdgcn_fence(__ATOMIC_ACQUIRE, "agent");
            xb_add(&bar[XB_XGEN(b.x)], 1u);
            asm volatile("s_waitcnt vmcnt(0)" ::: "memory");
        } else {
            XB_SPIN(xb_ld(&bar[XB_XGEN(b.x)]) == gen, bar);
            __builtin_amdgcn_fence(__ATOMIC_ACQUIRE, "agent");
            asm volatile("s_waitcnt vmcnt(0)" ::: "memory");
        }
    }
    __syncthreads();
}

struct Args { const float* in[22]; float* out; unsigned char* ws; int ph_lo, ph_hi; };
enum { I_XIN = 0, I_C, I_ADAW, I_ADAB, I_NMG, I_WIN, I_LBP, I_HNG, I_LNG, I_LNB, I_GWS, I_GBS, I_GNG, I_WOUT, I_NFG, I_RW, I_RB, I_WGU, I_BGU, I_WD, I_BD, I_FG };

template <bool GU>
__device__ __forceinline__ void cvt_item(const float* W, int K, int N, bf16* WT, int item, int lane) {
    const int nblk = N / 64, kb = item / nblk, nb = item - kb * nblk, k0 = 64 * kb, n0 = 64 * nb, q = lane >> 4, c = lane & 15;
    const float* src = W + (size_t)(k0 + 16 * q) * N + n0 + 4 * c;
    f32x4 v[16];
#pragma unroll
    for (int i = 0; i < 16; ++i) v[i] = __builtin_nontemporal_load((const f32x4*)(src + (size_t)i * N));
#pragma unroll
    for (int j = 0; j < 4; ++j) { const int n = n0 + 4 * c + j; int np = n;
        if (GU) { const int hi = n >= 1024, nn = n - hi * 1024; np = ((nn >> 7) << 8) + hi * 128 + (nn & 127); }
        u32x4 lo, hi4;
        lo.x = pk2(v[0][j], v[1][j]); lo.y = pk2(v[2][j], v[3][j]); lo.z = pk2(v[4][j], v[5][j]); lo.w = pk2(v[6][j], v[7][j]);
        hi4.x = pk2(v[8][j], v[9][j]); hi4.y = pk2(v[10][j], v[11][j]); hi4.z = pk2(v[12][j], v[13][j]); hi4.w = pk2(v[14][j], v[15][j]);
        bf16* dst = WT + (size_t)np * K + k0 + 16 * q;
        *(u32x4*)dst = lo; *(u32x4*)(dst + 8) = hi4; }
}
constexpr int XITEMS = NE * (16 * 32 + 16 * 16);
constexpr int XI_P3 = 0, XI_P5 = 1536 * 8, XI_P0 = XI_P5 + 1024 * 8;
struct XItem { const float* W; bf16* WT; int N, r; bool gu; };
__device__ __forceinline__ XItem xitem(const Args& a, int id) {
    XItem x;
    if (id < 16384) { const int e = id >> 9; x.W = a.in[I_WGU] + (size_t)e * DM * 2048; x.WT = (bf16*)(a.ws + WS_WGU) + (size_t)e * 2048 * DM; x.N = 2048; x.r = id & 511; x.gu = true; }
    else if (id < XITEMS) { const int e = (id - 16384) >> 8; x.W = a.in[I_WD] + (size_t)e * DFF * DM; x.WT = (bf16*)(a.ws + WS_WD) + (size_t)e * DM * DFF; x.N = 1024; x.r = (id - 16384) & 255; x.gu = false; }
    else if (id < XITEMS + 768) { x.W = a.in[I_WIN]; x.WT = (bf16*)(a.ws + WS_WIN); x.N = NIN; x.r = id - XITEMS; x.gu = false; }
    else { x.W = a.in[I_WOUT]; x.WT = (bf16*)(a.ws + WS_WOUT); x.N = DM; x.r = id - XITEMS - 768; x.gu = false; }
    return x;
}
__device__ __forceinline__ void xcvt_load(const Args& a, int id, int lane, f32x4 (&v)[16]) {
    const XItem x = xitem(a, id);
    const int nblk = x.N / 64, kb = x.r / nblk, nb = x.r - kb * nblk, q = lane >> 4, c = lane & 15;
    const float* src = x.W + (size_t)(64 * kb + 16 * q) * x.N + 64 * nb + 4 * c;
#pragma unroll
    for (int i = 0; i < 16; ++i) v[i] = __builtin_nontemporal_load((const f32x4*)(src + (size_t)i * x.N));
}
__device__ __forceinline__ void xcvt_store(const Args& a, int id, int lane, const f32x4 (&v)[16]) {
    const XItem x = xitem(a, id);
    const int nblk = x.N / 64, kb = x.r / nblk, nb = x.r - kb * nblk, q = lane >> 4, c = lane & 15;
#pragma unroll
    for (int j = 0; j < 4; ++j) { const int n = 64 * nb + 4 * c + j; int np = n;
        if (x.gu) { const int hi = n >= 1024, nn = n - hi * 1024; np = ((nn >> 7) << 8) + hi * 128 + (nn & 127); }
        u32x4 lo, hi4;
        lo.x = pk2(v[0][j], v[1][j]); lo.y = pk2(v[2][j], v[3][j]); lo.z = pk2(v[4][j], v[5][j]); lo.w = pk2(v[6][j], v[7][j]);
        hi4.x = pk2(v[8][j], v[9][j]); hi4.y = pk2(v[10][j], v[11][j]); hi4.z = pk2(v[12][j], v[13][j]); hi4.w = pk2(v[14][j], v[15][j]);
        bf16* dst = x.WT + (size_t)np * 1024 + 64 * kb + 16 * q;
        *(u32x4*)dst = lo; *(u32x4*)(dst + 8) = hi4; }
}
__device__ __forceinline__ void xcvt_load_h(const Args& a, int id, int half, int lane, f32x4 (&v)[8]) {
    const bool gu = id < 16384; const int r0 = gu ? id : id - 16384, per = gu ? 512 : 256, e = r0 / per, r = r0 - e * per, N = gu ? 2048 : 1024;
    const float* W = gu ? a.in[I_WGU] + (size_t)e * DM * 2048 : a.in[I_WD] + (size_t)e * DFF * DM;
    const int nblk = N / 64, kb = r / nblk, nb = r - kb * nblk, q = lane >> 4, c = lane & 15;
    const float* src = W + (size_t)(64 * kb + 16 * q + 8 * half) * N + 64 * nb + 4 * c;
#pragma unroll
    for (int i = 0; i < 8; ++i) v[i] = __builtin_nontemporal_load((const f32x4*)(src + (size_t)i * N));
}
__device__ __forceinline__ void xcvt_store_h(const Args& a, int id, int half, int lane, const f32x4 (&v)[8]) {
    const bool gu = id < 16384; const int r0 = gu ? id : id - 16384, per = gu ? 512 : 256, e = r0 / per, r = r0 - e * per, N = gu ? 2048 : 1024;
    bf16* WT = gu ? (bf16*)(a.ws + WS_WGU) + (size_t)e * 2048 * DM : (bf16*)(a.ws + WS_WD) + (size_t)e * DM * DFF;
    const int nblk = N / 64, kb = r / nblk, nb = r - kb * nblk, q = lane >> 4, c = lane & 15;
#pragma unroll
    for (int j = 0; j < 4; ++j) { const int n = 64 * nb + 4 * c + j; int np = n;
        if (gu) { const int hi = n >= 1024, nn = n - hi * 1024; np = ((nn >> 7) << 8) + hi * 128 + (nn & 127); }
        u32x4 w; w.x = pk2(v[0][j], v[1][j]); w.y = pk2(v[2][j], v[3][j]); w.z = pk2(v[4][j], v[5][j]); w.w = pk2(v[6][j], v[7][j]);
        *(u32x4*)(WT + (size_t)np * 1024 + 64 * kb + 16 * q + 8 * half) = w; }
}
__device__ __forceinline__ void p0_prologue(const Args& a, LAS unsigned char* lds, int vcu, int G, int tid, int wave, int lane) {
    unsigned char* ws = a.ws;
    if (vcu < 96) {
        LAS float* cact = (LAS float*)lds;
        LAS float* ps = (LAS float*)(lds + 16384);
        { float cvv[8];
#pragma unroll
          for (int it = 0; it < 8; ++it) cvv[it] = a.in[I_C][tid + 512 * it];
#pragma unroll
          for (int it = 0; it < 8; ++it) cact[tid + 512 * it] = cvv[it] * fsigmoid(cvv[it]); }
        __syncthreads();
        const float* w = a.in[I_ADAW] + (size_t)(128 * wave) * 6144 + 64 * vcu + lane;
        float s0 = 0.f, s1 = 0.f, s2 = 0.f, s3 = 0.f;
#pragma unroll 64
        for (int k = 0; k < 128; ++k) { const float wv = w[(size_t)k * 6144]; const int kk = 128 * wave + k;
            s0 += cact[kk] * wv; s1 += cact[1024 + kk] * wv; s2 += cact[2048 + kk] * wv; s3 += cact[3072 + kk] * wv; }
        ps[(wave * 4 + 0) * 64 + lane] = s0; ps[(wave * 4 + 1) * 64 + lane] = s1; ps[(wave * 4 + 2) * 64 + lane] = s2; ps[(wave * 4 + 3) * 64 + lane] = s3;
        __syncthreads();
        if (wave < 4) { float s = a.in[I_ADAB][64 * vcu + lane];
#pragma unroll
            for (int w8 = 0; w8 < 8; ++w8) s += ps[(w8 * 4 + wave) * 64 + lane];
            ((float*)(ws + WS_MOD))[wave * 6144 + 64 * vcu + lane] = s; }
        asm volatile("s_waitcnt vmcnt(0)" ::: "memory");
        __syncthreads();
        if (tid == 0) { __builtin_amdgcn_fence(__ATOMIC_RELEASE, "agent"); asm volatile("s_waitcnt vmcnt(0)" ::: "memory");
            __hip_atomic_fetch_add((unsigned*)(ws + WS_CTL) + CW_MODRDY, 1u, __ATOMIC_RELAXED, __HIP_MEMORY_SCOPE_AGENT); }
    }
    if (vcu == G - 1) { const float p0 = a.in[I_LBP][tid], p1 = a.in[I_LBP][512 + tid]; ((float*)(ws + WS_LB))[tid] = fsigmoid(p0 - p1); }
    if (vcu >= 96 && vcu < 160) { bf16* wrh = (bf16*)(ws + WS_WRH); bf16* wrl = (bf16*)(ws + WS_WRL);
        { const int idx = (vcu - 96) * 512 + tid; const int k = idx >> 5, e = idx & 31; const float w = a.in[I_RW][idx];
            const unsigned hi = pk2(w, 0.f) & 0xffffu; const float r = w - __uint_as_float(hi << 16);
            const unsigned lo16 = pk2(r, 0.f) & 0xffffu, hi2 = (unsigned)__shfl_down((int)hi, 32), lo2 = (unsigned)__shfl_down((int)lo16, 32);
            if (lane < 32) { *(unsigned*)(wrh + e * 1024 + k) = hi | (hi2 << 16); *(unsigned*)(wrl + e * 1024 + k) = lo16 | (lo2 << 16); } } }
    const int gw = (vcu - 96) * 8 + wave, NGW = (G - 96) * 8;
    constexpr int I_IN = 16 * 48, I_OUT = 16 * 16, I_X = 0;
    constexpr int NITEMS = I_IN + I_OUT + I_X;
    const int it0 = vcu < 96 ? 0 : (int)((long)gw * NITEMS / NGW), it1 = vcu < 96 ? 0 : (int)((long)(gw + 1) * NITEMS / NGW);
#define P0_ID(it_) ((it_) < I_IN + I_OUT ? XITEMS + (it_) : XI_P0 + (it_) - (I_IN + I_OUT))
    f32x4 ca[16], cb[16];
    if (it0 < it1) xcvt_load(a, P0_ID(it0), lane, ca);
    for (int it = it0; it < it1; it += 2) {
        if (it + 1 < it1) xcvt_load(a, P0_ID(it + 1), lane, cb);
        xcvt_store(a, P0_ID(it), lane, ca);
        if (it + 2 < it1) xcvt_load(a, P0_ID(it + 2), lane, ca);
        if (it + 1 < it1) xcvt_store(a, P0_ID(it + 1), lane, cb);
    }
#undef P0_ID
}

__device__ __forceinline__ void mod_wait(const Args& a, int tid) {
    if (tid == 0) { unsigned* ctl = (unsigned*)(a.ws + WS_CTL); unsigned sp = 0;
        while (__hip_atomic_load(ctl + CW_MODRDY, __ATOMIC_RELAXED, __HIP_MEMORY_SCOPE_AGENT) < 96u) { __builtin_amdgcn_s_sleep(2);
            if ((++sp & 255u) == 0u) { if (__hip_atomic_load(ctl + CW_TMO, __ATOMIC_RELAXED, __HIP_MEMORY_SCOPE_AGENT)) break; if (sp > (1u << 20)) { __hip_atomic_store(ctl + CW_TMO, 1u, __ATOMIC_RELAXED, __HIP_MEMORY_SCOPE_AGENT); break; } } }
        __builtin_amdgcn_fence(__ATOMIC_ACQUIRE, "agent"); asm volatile("s_waitcnt vmcnt(0)" ::: "memory"); }
    __syncthreads();
}
__device__ __forceinline__ void h1_load4(const Args& a, int m0, int NGW, int lane, f32x4 (&v)[4][4], float (&rstd)[4]) {
#pragma unroll
    for (int r = 0; r < 4; ++r) { const int m = m0 + r * NGW; const f32x4* xr = (const f32x4*)(a.in[I_XIN] + (size_t)(m < MT ? m : 0) * DM) + lane;
#pragma unroll
        for (int j = 0; j < 4; ++j) v[r][j] = xr[64 * j]; }
#pragma unroll
    for (int r = 0; r < 4; ++r) { float ss = 0.f;
#pragma unroll
        for (int j = 0; j < 4; ++j) ss += (v[r][j].x * v[r][j].x + v[r][j].y * v[r][j].y) + (v[r][j].z * v[r][j].z + v[r][j].w * v[r][j].w);
        rstd[r] = rsqrtf(wave_sum(ss) * (1.0f / DM) + EPS); }
}
__device__ __forceinline__ void h1_store4(const Args& a, int m0, int NGW, int lane, const f32x4 (&v)[4][4], const float (&rstd)[4]) {
    const float* mod = (const float*)(a.ws + WS_MOD); bf16* H = (bf16*)(a.ws + WS_H);
    f32x4 gq[4];
#pragma unroll
    for (int j = 0; j < 4; ++j) gq[j] = *(const f32x4*)(a.in[I_NMG] + 4 * lane + 256 * j);
#pragma unroll
    for (int rp = 0; rp < 2; ++rp) { f32x4 shq[2][4], scq[2][4];
#pragma unroll
        for (int rr = 0; rr < 2; ++rr) { const int m = m0 + (2 * rp + rr) * NGW, b = (m < MT ? m : 0) / SEQ;
#pragma unroll
            for (int j = 0; j < 4; ++j) { const int c = 4 * lane + 256 * j; shq[rr][j] = *(const f32x4*)(mod + b * 6144 + c); scq[rr][j] = *(const f32x4*)(mod + b * 6144 + 1024 + c); } }
#pragma unroll
        for (int rr = 0; rr < 2; ++rr) { const int r = 2 * rp + rr, m = m0 + r * NGW;
            if (m < MT) { u32x2* o8 = (u32x2*)(H + (size_t)m * DM) + lane;
#pragma unroll
                for (int j = 0; j < 4; ++j) { const f32x4 h = (v[r][j] * rstd[r]) * gq[j] * (scq[rr][j] + 1.0f) + shq[rr][j]; u32x2 w; w.x = pk2(h.x, h.y); w.y = pk2(h.z, h.w); o8[64 * j] = w; } } } }
}
__device__ __forceinline__ void p1_h1(const Args& a, int vcu, int G, int tid, int wave, int lane) {
    const int gw = vcu * 8 + wave, NGW = G * 8;
    f32x4 v[4][4], v2[4][4]; float rstd[4], rstd2[4];
    h1_load4(a, gw, NGW, lane, v, rstd);
    h1_load4(a, gw + 4 * NGW, NGW, lane, v2, rstd2);
    mod_wait(a, tid);
    h1_store4(a, gw, NGW, lane, v, rstd);
    h1_store4(a, gw + 4 * NGW, NGW, lane, v2, rstd2);
    for (int m0 = gw + 8 * NGW; m0 < MT; m0 += 4 * NGW) { h1_load4(a, m0, NGW, lane, v, rstd); h1_store4(a, m0, NGW, lane, v, rstd); }
}

constexpr int RT_WH = 0, RT_WL = 66048, RT_LG = 132096, RT_SSQ = RT_LG + 16384, RT_SEL = RT_SSQ + 512, RT_GS = RT_SEL + 3584, RT_SH = RT_GS + 4096, RT_RB = RT_SH + 4096;
static_assert(RT_RB + 128 <= LDSCTL_OFF, "router lds");
__device__ __forceinline__ void p6_router(const Args& a, LAS unsigned char* lds, int vcu, int G, int tid, int wave, int lane, bool dry) {
    LAS float* LG = (LAS float*)(lds + RT_LG); LAS float* SSQ = (LAS float*)(lds + RT_SSQ);
    LAS int* sel_e = (LAS int*)(lds + RT_SEL); LAS int* sel_p = sel_e + 256; LAS int* hist = sel_p + 256; LAS int* base = hist + 32; LAS float* sel_g = (LAS float*)(base + 32);
    LAS float* GS = (LAS float*)(lds + RT_GS); LAS float* SH = (LAS float*)(lds + RT_SH); LAS float* RBL = (LAS float*)(lds + RT_RB);
    { const u32x4* wh = (const u32x4*)(a.ws + WS_WRH); const u32x4* wlo = (const u32x4*)(a.ws + WS_WRL);
      u32x4 th[8], tl[8];
#pragma unroll
      for (int it = 0; it < 8; ++it) { th[it] = wh[tid + 512 * it]; tl[it] = wlo[tid + 512 * it]; }
#pragma unroll
      for (int it = 0; it < 8; ++it) { const int idx = tid + 512 * it, e = idx >> 7, c = idx & 127; *(LAS u32x4*)(lds + RT_WH + e * 2064 + c * 16) = th[it]; *(LAS u32x4*)(lds + RT_WL + e * 2064 + c * 16) = tl[it]; } }
    if (tid < 32) { hist[tid] = 0; RBL[tid] = a.in[I_RB][tid]; }
    lds_barrier();
    const float* mod = (const float*)(a.ws + WS_MOD);
    const bf16* xmid = (const bf16*)(a.ws + WS_XMID);
    bf16* H = (bf16*)(a.ws + WS_H);
    float* lgate = (float*)(a.ws + WS_LGATE);
    int* lists = (int*)(a.ws + WS_LISTS);
    unsigned* cntg = (unsigned*)(a.ws + WS_CTL) + CW_CNT;
    const int rb = wave & 3, kh = wave >> 2, fr = lane & 15, q = lane >> 4;
    for (int blk = vcu; blk < MT / 64; blk += G) {
        const int row0 = blk * 64, b = row0 / SEQ, row = row0 + 16 * rb + fr;
        for (int k = tid; k < DM; k += 512) { GS[k] = a.in[I_NFG][k] * (mod[b * 6144 + 4096 + k] + 1.0f); SH[k] = mod[b * 6144 + 3072 + k]; }
        const bf16* xr = xmid + (size_t)row * DM + 512 * kh + 8 * q;
        f32x4 x[16][2]; float ss = 0.f;
        { u32x4 xb[16];
#pragma unroll
          for (int ks = 0; ks < 16; ++ks) xb[ks] = *(const u32x4*)(xr + 32 * ks);
#pragma unroll
          for (int ks = 0; ks < 16; ++ks) { x[ks][0] = (f32x4){bflo(xb[ks].x), bfhi(xb[ks].x), bflo(xb[ks].y), bfhi(xb[ks].y)}; x[ks][1] = (f32x4){bflo(xb[ks].z), bfhi(xb[ks].z), bflo(xb[ks].w), bfhi(xb[ks].w)}; } }
#pragma unroll
        for (int ks = 0; ks < 16; ++ks)
#pragma unroll
            for (int hh = 0; hh < 2; ++hh) ss += (x[ks][hh].x * x[ks][hh].x + x[ks][hh].y * x[ks][hh].y) + (x[ks][hh].z * x[ks][hh].z + x[ks][hh].w * x[ks][hh].w);
        ss += __shfl_xor(ss, 16); ss += __shfl_xor(ss, 32);
        if (q == 0) SSQ[kh * 64 + 16 * rb + fr] = ss;
        lds_barrier();
        const float rstd = rsqrtf((SSQ[16 * rb + fr] + SSQ[64 + 16 * rb + fr]) * (1.0f / DM) + EPS);
        f32x4 acc[2] = {(f32x4){0.f, 0.f, 0.f, 0.f}, (f32x4){0.f, 0.f, 0.f, 0.f}};
#pragma unroll
        for (int ks = 0; ks < 16; ++ks) { const int k = 512 * kh + 32 * ks + 8 * q;
            unsigned hp[4], lp[4];
#pragma unroll
            for (int hh = 0; hh < 2; ++hh) { const f32x4 gs = *(const LAS f32x4*)(GS + k + 4 * hh), sh = *(const LAS f32x4*)(SH + k + 4 * hh);
                const f32x4 h = (x[ks][hh] * rstd) * gs + sh;
                hp[2 * hh] = pk2(h.x, h.y); hp[2 * hh + 1] = pk2(h.z, h.w);
                lp[2 * hh] = pk2(h.x - bflo(hp[2 * hh]), h.y - bfhi(hp[2 * hh])); lp[2 * hh + 1] = pk2(h.z - bflo(hp[2 * hh + 1]), h.w - bfhi(hp[2 * hh + 1])); }
            *(u32x4*)(H + (size_t)row * DM + k) = (u32x4){hp[0], hp[1], hp[2], hp[3]};
            const bf16x8 ah = mk_frag(hp[0], hp[1], hp[2], hp[3]), al = mk_frag(lp[0], lp[1], lp[2], lp[3]);
#pragma unroll
            for (int nb = 0; nb < 2; ++nb) { const bf16x8 bh = *(const LAS bf16x8*)(lds + RT_WH + (16 * nb + fr) * 2064 + k * 2), bl = *(const LAS bf16x8*)(lds + RT_WL + (16 * nb + fr) * 2064 + k * 2);
                acc[nb] = __builtin_amdgcn_mfma_f32_16x16x32_bf16(ah, bh, acc[nb], 0, 0, 0); acc[nb] = __builtin_amdgcn_mfma_f32_16x16x32_bf16(al, bh, acc[nb], 0, 0, 0); acc[nb] = __builtin_amdgcn_mfma_f32_16x16x32_bf16(ah, bl, acc[nb], 0, 0, 0); }
            asm volatile("" ::: "memory"); }
#pragma unroll
        for (int nb = 0; nb < 2; ++nb)
#pragma unroll
            for (int r = 0; r < 4; ++r) LG[(kh * 64 + 16 * rb + 4 * q + r) * 32 + 16 * nb + fr] = acc[nb][r];
        lds_barrier();
#pragma unroll 1
        for (int it = 0; it < 4; ++it) { const int r = 8 * wave + 2 * it + (lane >> 5), e = lane & 31;
            float lv[32];
#pragma unroll
            for (int c = 0; c < 8; ++c) { const f32x4 a0 = *(const LAS f32x4*)(LG + r * 32 + 4 * c), a1 = *(const LAS f32x4*)(LG + (64 + r) * 32 + 4 * c), rbv = *(const LAS f32x4*)(RBL + 4 * c);
                const f32x4 t = (a0 + a1) + rbv; lv[4 * c] = t.x; lv[4 * c + 1] = t.y; lv[4 * c + 2] = t.z; lv[4 * c + 3] = t.w; }
            const float val = (LG[r * 32 + e] + LG[(64 + r) * 32 + e]) + RBL[e];
            int rank = 0;
#pragma unroll
            for (int e2 = 0; e2 < 32; ++e2) rank += (lv[e2] > val || (lv[e2] == val && e2 < e)) ? 1 : 0;
            float mx = val;
#pragma unroll
            for (int o = 1; o < 32; o <<= 1) mx = fmaxf(mx, __shfl_xor(mx, o));
            const float ex = rank < 4 ? __expf(val - mx) : 0.f; float sm = ex;
#pragma unroll
            for (int o = 1; o < 32; o <<= 1) sm += __shfl_xor(sm, o);
            if (rank < 4) { const int li = r * 4 + rank; sel_g[li] = ex * __builtin_amdgcn_rcpf(sm); sel_e[li] = e; if (!dry) sel_p[li] = __hip_atomic_fetch_add(&hist[e], 1, __ATOMIC_RELAXED, __HIP_MEMORY_SCOPE_WORKGROUP); }
        }
        lds_barrier();
        if (!dry) {
            int t2 = tid; asm volatile("" : "+v"(t2));
            if (t2 < 32) base[t2] = (int)__hip_atomic_fetch_add(cntg + CNT_STRIDE * t2, (unsigned)hist[t2], __ATOMIC_RELAXED, __HIP_MEMORY_SCOPE_AGENT);
            lds_barrier();
            if (tid < 256) { const int e = sel_e[tid]; const size_t li = (size_t)e * LSTRIDE + base[e] + sel_p[tid]; lists[li] = (row0 + (tid >> 2)) * 4 + (tid & 3); lgate[li] = sel_g[tid]; }
            lds_barrier();
            if (tid < 32) hist[tid] = 0;
        }
        lds_barrier();
    }
}

typedef __attribute__((__vector_size__(8 * sizeof(short)))) short bf16x8v;
constexpr int HG_T = 0;
constexpr int HG_QT = 4096;
constexpr int HG_QH = HG_QT + 17408;
constexpr int HG_KH = HG_QH + 17408;
constexpr int HG_VT = HG_KH + 43520;
constexpr int HG_KD = HG_VT + 18432;
constexpr int HG_SS = HG_KD + 18432;
static_assert(HG_SS + 512 <= LDSCTL_OFF, "hgrn lds");

#define HG_LOAD_A(unit_, L_, V_) do { const int _bh = (unit_) >> 6, _c = (unit_) & 63; const bf16* _zp = Z + ((size_t)(_bh >> 2) * SEQ + _c * 64 + 8 * wave) * NIN + (_bh & 3) * 128 + 2 * lane; \
    _Pragma("unroll") for (int _i = 0; _i < 8; ++_i) { L_[_i] = *(const unsigned*)(_zp + (size_t)_i * NIN + 512); V_[_i] = *(const unsigned*)(_zp + (size_t)_i * NIN + 1024); } } while (0)
__device__ __forceinline__ void hgrnA_phase(const Args& a, LAS unsigned char* lds, int bx, int G, int wave, int lane) {
    const bf16* Z = (const bf16*)(a.ws + WS_Z); bf16* KVT = (bf16*)(a.ws + WS_KV); float* DEC = (float*)(a.ws + WS_DEC);
    const int fr = lane & 15, q = lane >> 4;
    unsigned pl[8], pv[8];
    if (bx < 1024) HG_LOAD_A(bx, pl, pv);
    for (int unit = bx; unit < 1024; unit += G) {
        unsigned cl[8], vw[8];
#pragma unroll
        for (int i = 0; i < 8; ++i) { cl[i] = pl[i]; vw[i] = pv[i]; }
        if (unit + G < 1024) HG_LOAD_A(unit + G, pl, pv);
        float f0[8], f1[8], s0 = 0.f, s1 = 0.f;
#pragma unroll
        for (int i = 0; i < 8; ++i) { const float l0 = bflo(cl[i]), l1 = bfhi(cl[i]); s0 += l0; s1 += l1; f0[i] = __builtin_amdgcn_exp2f(l0); f1[i] = __builtin_amdgcn_exp2f(l1); }
        LAS float* T = (LAS float*)(lds + HG_T);
        *(LAS f32x2*)(T + wave * 128 + 2 * lane) = (f32x2){s0, s1};
        lds_barrier();
        float suf0 = 0.f, suf1 = 0.f, tot0 = 0.f, tot1 = 0.f;
#pragma unroll
        for (int w = 0; w < 8; ++w) { const f32x2 t = *(const LAS f32x2*)(T + w * 128 + 2 * lane); if (w > wave) { suf0 += t.x; suf1 += t.y; } tot0 += t.x; tot1 += t.y; }
        float S0 = __builtin_amdgcn_exp2f(suf0), S1 = __builtin_amdgcn_exp2f(suf1);
        float kd0[8], kd1[8];
#pragma unroll
        for (int i = 7; i >= 0; --i) { kd0[i] = (1.0f - f0[i]) * S0; kd1[i] = (1.0f - f1[i]) * S1; S0 *= f0[i]; S1 *= f1[i]; }
        { u32x4 w0 = {pk2(kd0[0], kd0[1]), pk2(kd0[2], kd0[3]), pk2(kd0[4], kd0[5]), pk2(kd0[6], kd0[7])}, w1 = {pk2(kd1[0], kd1[1]), pk2(kd1[2], kd1[3]), pk2(kd1[4], kd1[5]), pk2(kd1[6], kd1[7])};
          *(LAS u32x4*)(lds + HG_KD + (2 * lane) * 144 + 16 * wave) = w0; *(LAS u32x4*)(lds + HG_KD + (2 * lane + 1) * 144 + 16 * wave) = w1; }
        { u32x4 w0, w1;
          w0.x = (vw[0] & 0xffffu) | (vw[1] << 16); w0.y = (vw[2] & 0xffffu) | (vw[3] << 16); w0.z = (vw[4] & 0xffffu) | (vw[5] << 16); w0.w = (vw[6] & 0xffffu) | (vw[7] << 16);
          w1.x = (vw[0] >> 16) | (vw[1] & 0xffff0000u); w1.y = (vw[2] >> 16) | (vw[3] & 0xffff0000u); w1.z = (vw[4] >> 16) | (vw[5] & 0xffff0000u); w1.w = (vw[6] >> 16) | (vw[7] & 0xffff0000u);
          *(LAS u32x4*)(lds + HG_VT + (2 * lane) * 144 + 16 * wave) = w0; *(LAS u32x4*)(lds + HG_VT + (2 * lane + 1) * 144 + 16 * wave) = w1; }
        if (wave == 0) *(f32x2*)(DEC + (size_t)unit * 128 + 2 * lane) = (f32x2){__builtin_amdgcn_exp2f(tot0), __builtin_amdgcn_exp2f(tot1)};
        lds_barrier();
        f32x4 acc[8];
#pragma unroll
        for (int n = 0; n < 8; ++n) acc[n] = (f32x4){0.f, 0.f, 0.f, 0.f};
#pragma unroll
        for (int ks = 0; ks < 2; ++ks) { const bf16x8 af = *(const LAS bf16x8*)(lds + HG_KD + (16 * wave + fr) * 144 + ks * 64 + q * 16);
#pragma unroll
            for (int n = 0; n < 8; ++n) { const bf16x8 bfr = *(const LAS bf16x8*)(lds + HG_VT + (16 * n + fr) * 144 + ks * 64 + q * 16); acc[n] = __builtin_amdgcn_mfma_f32_16x16x32_bf16(af, bfr, acc[n], 0, 0, 0); } }
        bf16* kv = KVT + (size_t)unit * 16384 + 16 * wave + 4 * q;
#pragma unroll
        for (int n = 0; n < 8; ++n) { u32x2 w = {pk2(acc[n][0], acc[n][1]), pk2(acc[n][2], acc[n][3])}; *(u32x2*)(kv + (size_t)(16 * n + fr) * 128) = w; }
        lds_barrier();
    }
}
__device__ __forceinline__ void hgrnB_scan(bf16* KVT, bf16* OUTT, const float* DEC, int gtid, int nthreads) {
    for (int idx = gtid; idx < 16 * 128 * 64; idx += nthreads) {
        const int bh = idx >> 13, rem = idx & 8191, vv = rem >> 6, kp = rem & 63;
        unsigned* p = (unsigned*)(KVT + (size_t)bh * 64 * 16384 + (size_t)vv * 128 + 2 * kp);
        unsigned* po = (unsigned*)(OUTT + (size_t)bh * 64 * 16384 + (size_t)vv * 128 + 2 * kp);
        const float* d = DEC + (size_t)bh * 64 * 128 + 2 * kp;
        float s0 = 0.f, s1 = 0.f;
#pragma unroll 1
        for (int c0 = 0; c0 < 64; c0 += 32) {
            unsigned w[32]; f32x2 dd[32];
#pragma unroll
            for (int i = 0; i < 32; ++i) { w[i] = p[(size_t)(c0 + i) * 8192]; dd[i] = *(const f32x2*)(d + (c0 + i) * 128); }
#pragma unroll
            for (int i = 0; i < 32; ++i) { po[(size_t)(c0 + i) * 8192] = pk2(s0, s1); s0 = dd[i].x * s0 + bflo(w[i]); s1 = dd[i].y * s1 + bfhi(w[i]); }
        }
    }
}
#define HG_LOAD_C(unit_, Q_, L_, V_) do { const int _bh = (unit_) >> 6, _c = (unit_) & 63; const bf16* _zp = Z + ((size_t)(_bh >> 2) * SEQ + _c * 64 + 8 * wave) * NIN + (_bh & 3) * 128 + 2 * lane; \
    _Pragma("unroll") for (int _i = 0; _i < 8; ++_i) { Q_[_i] = *(const unsigned*)(_zp + (size_t)_i * NIN); L_[_i] = *(const unsigned*)(_zp + (size_t)_i * NIN + 512); V_[_i] = *(const unsigned*)(_zp + (size_t)_i * NIN + 1024); } } while (0)
__device__ __forceinline__ void hgrnC_phase(const Args& a, LAS unsigned char* lds, int bx, int G, int wave, int lane) {
    const bf16* Z = (const bf16*)(a.ws + WS_Z); const bf16* SPT = (const bf16*)(a.ws + WS_KV); const float* ng = a.in[I_HNG]; bf16* YMIX = (bf16*)(a.ws + WS_YMIX);
    const int fr = lane & 15, q = lane >> 4, ti = wave >> 1, nh = wave & 1, own = wave >> 1;
    unsigned pq[8], pl[8], pv[8];
    if (bx < 1024) HG_LOAD_C(bx, pq, pl, pv);
    for (int unit = bx; unit < 1024; unit += G) {
        const int bh = unit >> 6, c = unit & 63, b = bh >> 2, h = bh & 3;
        const size_t rowc = (size_t)b * SEQ + c * 64;
        unsigned cq[8], cl[8], vw[8];
#pragma unroll
        for (int i = 0; i < 8; ++i) { cq[i] = pq[i]; cl[i] = pl[i]; vw[i] = pv[i]; }
        bf16x8 sf[4][4];
        { const bf16* sp = SPT + (size_t)unit * 16384 + (size_t)(64 * nh + fr) * 128 + 8 * q;
#pragma unroll
          for (int n = 0; n < 4; ++n)
#pragma unroll
              for (int ks = 0; ks < 4; ++ks) sf[n][ks] = *(const bf16x8*)(sp + n * 16 * 128 + ks * 32); }
        if (unit + G < 1024) HG_LOAD_C(unit + G, pq, pl, pv);
        const int xid = 16384 + unit * 8 + wave;
        f32x4 cv[8]; xcvt_load_h(a, xid, 0, lane, cv);
        float f0[8], f1[8], s0 = 0.f, s1 = 0.f;
#pragma unroll
        for (int i = 0; i < 8; ++i) { const float l0 = bflo(cl[i]), l1 = bfhi(cl[i]); s0 += l0; s1 += l1; f0[i] = __builtin_amdgcn_exp2f(l0); f1[i] = __builtin_amdgcn_exp2f(l1); }
        LAS float* T = (LAS float*)(lds + HG_T);
        *(LAS f32x2*)(T + wave * 128 + 2 * lane) = (f32x2){s0, s1};
        lds_barrier();
        float off0 = 0.f, off1 = 0.f, ro0 = 0.f, ro1 = 0.f; float cr0[4], cr1[4];
        { float a0 = 0.f, a1 = 0.f;
#pragma unroll
          for (int w = 0; w < 8; ++w) { if ((w & 1) == 0) { cr0[w >> 1] = a0; cr1[w >> 1] = a1; }
              const f32x2 t = *(const LAS f32x2*)(T + w * 128 + 2 * lane);
              if (w < wave) { off0 += t.x; off1 += t.y; } if (w < (wave & ~1)) { ro0 += t.x; ro1 += t.y; } a0 += t.x; a1 += t.y; } }
        const float eoff0 = __builtin_amdgcn_exp2f(off0), eoff1 = __builtin_amdgcn_exp2f(off1), eoo0 = __builtin_amdgcn_exp2f(off0 - ro0), eoo1 = __builtin_amdgcn_exp2f(off1 - ro1);
        float ck0[4], ck1[4];
#pragma unroll
        for (int ip = 0; ip < 4; ++ip) { ck0[ip] = __builtin_amdgcn_exp2f(fminf(cr0[ip] - (off0 + s0), 100.f)); ck1[ip] = __builtin_amdgcn_exp2f(fminf(cr1[ip] - (off1 + s1), 100.f)); }
        { float E0 = 1.f, E1 = 1.f;
#pragma unroll
          for (int i = 0; i < 8; ++i) { const int t = 8 * wave + i; E0 *= f0[i]; E1 *= f1[i]; const float q0 = bflo(cq[i]), q1 = bfhi(cq[i]);
              *(LAS unsigned*)(lds + HG_QT + t * 272 + 4 * lane) = pk2(q0 * (E0 * eoff0), q1 * (E1 * eoff1));
              *(LAS unsigned*)(lds + HG_QH + t * 272 + 4 * lane) = pk2(q0 * (E0 * eoo0), q1 * (E1 * eoo1)); } }
        { float S0 = 1.f, S1 = 1.f;
#pragma unroll
          for (int i = 7; i >= 0; --i) { const int t = 8 * wave + i; const float k0 = (1.0f - f0[i]) * S0, k1 = (1.0f - f1[i]) * S1; S0 *= f0[i]; S1 *= f1[i];
#pragma unroll
              for (int ip = 0; ip < 4; ++ip) { if (ip >= own) *(LAS unsigned*)(lds + HG_KH + (8 * ip * (ip + 1) + t) * 272 + 4 * lane) = pk2(k0 * ck0[ip], k1 * ck1[ip]); } } }
        { u32x4 w0, w1;
          w0.x = (vw[0] & 0xffffu) | (vw[1] << 16); w0.y = (vw[2] & 0xffffu) | (vw[3] << 16); w0.z = (vw[4] & 0xffffu) | (vw[5] << 16); w0.w = (vw[6] & 0xffffu) | (vw[7] << 16);
          w1.x = (vw[0] >> 16) | (vw[1] & 0xffff0000u); w1.y = (vw[2] >> 16) | (vw[3] & 0xffff0000u); w1.z = (vw[4] >> 16) | (vw[5] & 0xffff0000u); w1.w = (vw[6] >> 16) | (vw[7] & 0xffff0000u);
          *(LAS u32x4*)(lds + HG_VT + (2 * lane) * 144 + 16 * wave) = w0; *(LAS u32x4*)(lds + HG_VT + (2 * lane + 1) * 144 + 16 * wave) = w1; }
        float ngv[4]; unsigned short gzv[4][4];
#pragma unroll
        for (int n = 0; n < 4; ++n) ngv[n] = ng[h * 128 + 64 * nh + 16 * n + fr];
#pragma unroll
        for (int r = 0; r < 4; ++r)
#pragma unroll
            for (int n = 0; n < 4; ++n) gzv[r][n] = Z[(rowc + 16 * ti + 4 * q + r) * NIN + 1536 + h * 128 + 64 * nh + 16 * n + fr];
        lds_barrier();
        xcvt_store_h(a, xid, 0, lane, cv); xcvt_load_h(a, xid, 1, lane, cv);
        f32x4 acc[4];
#pragma unroll
        for (int n = 0; n < 4; ++n) acc[n] = (f32x4){0.f, 0.f, 0.f, 0.f};
#pragma unroll
        for (int ks = 0; ks < 4; ++ks) { const bf16x8 qa = *(const LAS bf16x8*)(lds + HG_QT + (16 * ti + fr) * 272 + ks * 64 + q * 16);
#pragma unroll
            for (int n = 0; n < 4; ++n) acc[n] = __builtin_amdgcn_mfma_f32_16x16x32_bf16(qa, sf[n][ks], acc[n], 0, 0, 0); }
        bf16x8 qh[4];
#pragma unroll
        for (int ks = 0; ks < 4; ++ks) qh[ks] = *(const LAS bf16x8*)(lds + HG_QH + (16 * ti + fr) * 272 + ks * 64 + q * 16);
        unsigned P[4][2];
#pragma unroll
        for (int j = 0; j < 4; ++j) { P[j][0] = 0u; P[j][1] = 0u;
            if (j <= ti) { f32x4 st = (f32x4){0.f, 0.f, 0.f, 0.f};
#pragma unroll
                for (int ks = 0; ks < 4; ++ks) { const bf16x8 kf = *(const LAS bf16x8*)(lds + HG_KH + (8 * ti * (ti + 1) + 16 * j + fr) * 272 + ks * 64 + q * 16); st = __builtin_amdgcn_mfma_f32_16x16x32_bf16(kf, qh[ks], st, 0, 0, 0); }
                if (j == ti) {
#pragma unroll
                    for (int r = 0; r < 4; ++r) st[r] = (4 * q + r <= fr) ? st[r] : 0.f; }
                P[j][0] = pk2(st[0], st[1]); P[j][1] = pk2(st[2], st[3]); } }
#pragma unroll
        for (int jp = 0; jp < 2; ++jp) { if (2 * jp <= ti) { const bf16x8 pa = mk_frag(P[2 * jp][0], P[2 * jp][1], P[2 * jp + 1][0], P[2 * jp + 1][1]);
#pragma unroll
            for (int n = 0; n < 4; ++n) { const int vv = 64 * nh + 16 * n + fr;
                const u32x2 lo = *(const LAS u32x2*)(lds + HG_VT + vv * 144 + (32 * jp + 4 * q) * 2), hi = *(const LAS u32x2*)(lds + HG_VT + vv * 144 + (32 * jp + 16 + 4 * q) * 2);
                acc[n] = __builtin_amdgcn_mfma_f32_16x16x32_bf16(pa, mk_frag(lo.x, lo.y, hi.x, hi.y), acc[n], 0, 0, 0); } } }
        LAS float* SS = (LAS float*)(lds + HG_SS);
        float ssq[4];
#pragma unroll
        for (int r = 0; r < 4; ++r) { float sq = 0.f;
#pragma unroll
            for (int n = 0; n < 4; ++n) sq += acc[n][r] * acc[n][r];
            sq += __shfl_xor(sq, 1); sq += __shfl_xor(sq, 2); sq += __shfl_xor(sq, 4); sq += __shfl_xor(sq, 8); ssq[r] = sq; }
        if (fr == 0) {
#pragma unroll
            for (int r = 0; r < 4; ++r) SS[(16 * ti + 4 * q + r) * 2 + nh] = ssq[r]; }
        lds_barrier();
#pragma unroll
        for (int r = 0; r < 4; ++r) { const int t = 16 * ti + 4 * q + r; const float rstd = rsqrtf((SS[t * 2] + SS[t * 2 + 1]) * (1.0f / 128.0f) + EPS);
#pragma unroll
            for (int n = 0; n < 4; ++n) { const int col = h * 128 + 64 * nh + 16 * n + fr; const float val = acc[n][r] * rstd * ngv[n] * bf2f(gzv[r][n]), oth = __shfl_xor(val, 1);
                if ((fr & 1) == 0) *(unsigned*)(YMIX + (rowc + t) * DM + col) = pk2(val, oth); } }
        xcvt_store_h(a, xid, 1, lane, cv);
        lds_barrier();
    }
}

constexpr int GM_WS = 0, GM_VT = 34816;
__device__ __forceinline__ void gmlp_unit(const Args& a, LAS unsigned char* lds, int unit, int tid, int wave, int lane, int xid) {
    const int g = unit & 3, bn = unit >> 2, fr = lane & 15, q = lane >> 4; const size_t r0 = (size_t)bn * 128;
    const bf16* Z = (const bf16*)(a.ws + WS_Z); bf16* YMIX = (bf16*)(a.ws + WS_YMIX);
    const f32x4* wsg = (const f32x4*)(a.in[I_GWS] + (size_t)g * 16384);
    f32x4 wv[8];
#pragma unroll
    for (int it = 0; it < 8; ++it) wv[it] = wsg[tid + 512 * it];
#pragma unroll
    for (int it = 0; it < 8; ++it) { const int idx = tid + 512 * it, t = idx >> 5, s = 4 * (idx & 31); f32x4 w = wv[it];
        w.x = (s <= t) ? w.x : 0.f; w.y = (s + 1 <= t) ? w.y : 0.f; w.z = (s + 2 <= t) ? w.z : 0.f; w.w = (s + 3 <= t) ? w.w : 0.f;
        *(LAS u32x2*)(lds + GM_WS + t * 272 + s * 2) = (u32x2){pk2(w.x, w.y), pk2(w.z, w.w)}; }
    u32x4 xc[16];
    { const u32x4* zr = (const u32x4*)(Z + (r0 + 16 * wave + fr) * NIN + 2560) + q;
#pragma unroll
      for (int j = 0; j < 16; ++j) xc[j] = zr[4 * j]; }
    { float sm = 0.f, sq = 0.f;
#pragma unroll
      for (int j = 0; j < 16; ++j) { const float e[8] = {bflo(xc[j].x), bfhi(xc[j].x), bflo(xc[j].y), bfhi(xc[j].y), bflo(xc[j].z), bfhi(xc[j].z), bflo(xc[j].w), bfhi(xc[j].w)};
#pragma unroll
          for (int t = 0; t < 8; ++t) { sm += e[t]; sq += e[t] * e[t]; } }
      sm += __shfl_xor(sm, 16); sm += __shfl_xor(sm, 32); sq += __shfl_xor(sq, 16); sq += __shfl_xor(sq, 32);
      const float mu = sm * (1.0f / 512.0f), rstd = rsqrtf(fmaxf(sq * (1.0f / 512.0f) - mu * mu, 0.f) + EPS);
      const int row = 16 * wave + fr;
#pragma unroll
      for (int jj = 0; jj < 4; ++jj) { const u32x4 x = (g == 0) ? xc[jj] : (g == 1) ? xc[4 + jj] : (g == 2) ? xc[8 + jj] : xc[12 + jj];
          const float e[8] = {bflo(x.x), bfhi(x.x), bflo(x.y), bfhi(x.y), bflo(x.z), bfhi(x.z), bflo(x.w), bfhi(x.w)}; const int d0 = 8 * (q + 4 * jj);
          const f32x4 lg0 = *(const f32x4*)(a.in[I_LNG] + g * 128 + d0), lg1 = *(const f32x4*)(a.in[I_LNG] + g * 128 + d0 + 4), lb0 = *(const f32x4*)(a.in[I_LNB] + g * 128 + d0), lb1 = *(const f32x4*)(a.in[I_LNB] + g * 128 + d0 + 4);
          const float lgv[8] = {lg0.x, lg0.y, lg0.z, lg0.w, lg1.x, lg1.y, lg1.z, lg1.w}, lbv[8] = {lb0.x, lb0.y, lb0.z, lb0.w, lb1.x, lb1.y, lb1.z, lb1.w};
#pragma unroll
          for (int t = 0; t < 8; ++t) { const float val = (e[t] - mu) * rstd * lgv[t] + lbv[t]; const float oth = __shfl_xor(val, 1);
              if ((fr & 1) == 0) *(LAS unsigned*)(lds + GM_VT + (d0 + t) * 272 + row * 2) = pk2(val, oth); } } }
    float gnv[8], bsv4[4]; unsigned short uzv[4][8];
#pragma unroll
    for (int n = 0; n < 8; ++n) gnv[n] = a.in[I_GNG][g * 128 + 16 * n + fr];
#pragma unroll
    for (int r = 0; r < 4; ++r) { bsv4[r] = a.in[I_GBS][g * 128 + 16 * wave + 4 * q + r];
#pragma unroll
        for (int n = 0; n < 8; ++n) uzv[r][n] = Z[(r0 + 16 * wave + 4 * q + r) * NIN + 2048 + g * 128 + 16 * n + fr]; }
    lds_barrier();
    f32x4 acc[8];
#pragma unroll
    for (int n = 0; n < 8; ++n) acc[n] = (f32x4){0.f, 0.f, 0.f, 0.f};
    const int nks = (wave + 2) >> 1;
#pragma unroll
    for (int ks = 0; ks < 4; ++ks) { if (ks < nks) { const bf16x8 af = *(const LAS bf16x8*)(lds + GM_WS + (16 * wave + fr) * 272 + ks * 64 + q * 16);
#pragma unroll
        for (int n = 0; n < 8; ++n) { const bf16x8 bfr = *(const LAS bf16x8*)(lds + GM_VT + (16 * n + fr) * 272 + ks * 64 + q * 16); acc[n] = __builtin_amdgcn_mfma_f32_16x16x32_bf16(af, bfr, acc[n], 0, 0, 0); } } }
#pragma unroll
    for (int r = 0; r < 4; ++r) { const int t = 16 * wave + 4 * q + r; const float bsv = bsv4[r]; float y[8]; float s = 0.f;
#pragma unroll
        for (int n = 0; n < 8; ++n) { const float u = bf2f(uzv[r][n]); y[n] = u * (acc[n][r] + bsv); s += y[n] * y[n]; }
        s += __shfl_xor(s, 1); s += __shfl_xor(s, 2); s += __shfl_xor(s, 4); s += __shfl_xor(s, 8);
        const float rstd = rsqrtf(s * (1.0f / 128.0f) + EPS);
#pragma unroll
        for (int n = 0; n < 8; ++n) { const int d = 16 * n + fr; const float val = y[n] * rstd * gnv[n], oth = __shfl_xor(val, 1);
            if ((fr & 1) == 0) *(unsigned*)(YMIX + (r0 + t) * DM + 512 + g * 128 + d) = pk2(val, oth); } }
    lds_barrier();
}

__device__ __forceinline__ void moe_table(const Args& a, volatile LAS unsigned* MISC, int wave, int lane) {
    if (wave == 0) {
        unsigned* cntg = (unsigned*)(a.ws + WS_CTL) + CW_CNT;
        const int c = lane < 32 ? (int)__hip_atomic_load(cntg + CNT_STRIDE * lane, __ATOMIC_RELAXED, __HIP_MEMORY_SCOPE_AGENT) : 0;
        const int nb = (c + 255) >> 8; int incl = nb;
#pragma unroll
        for (int o = 1; o < 32; o <<= 1) { const int t = __shfl_up(incl, o); if (lane >= o) incl += t; }
        if (lane < 32) { MISC[MOE_TAB + lane] = (unsigned)c; MISC[MOE_TAB + 32 + lane] = (unsigned)(incl - nb); }
        if (lane == 31) MISC[MOE_TAB + 64] = (unsigned)incl;
    }
    __syncthreads();
}

__device__ __forceinline__ void p9_final(const Args& a, LAS unsigned char* lds, int vcu, int G, int tid, int wave, int lane) {
    const int gw = vcu * 8 + wave, NGW = G * 8, c0 = 16 * lane;
    const float* mod = (const float*)(a.ws + WS_MOD);
    const bf16* xmid = (const bf16*)(a.ws + WS_XMID);
    const unsigned char* ys = (const unsigned char*)(a.ws + WS_YSLOT);
    LAS float* G2 = (LAS float*)lds;
    { float t8[8];
#pragma unroll
      for (int it = 0; it < 8; ++it) { const int i = tid + 512 * it; t8[it] = mod[(i >> 10) * 6144 + 5120 + (i & 1023)]; }
#pragma unroll
      for (int it = 0; it < 8; ++it) G2[tid + 512 * it] = t8[it]; }
    f32x4 fg[4];
#pragma unroll
    for (int j = 0; j < 4; ++j) fg[j] = *(const f32x4*)(a.in[I_FG] + c0 + 4 * j);
    lds_barrier();
    for (int m0 = gw; m0 < MT; m0 += 4 * NGW) {
        u32x4 yw[4][4]; u32x4 xw[4][2];
#pragma unroll
        for (int r = 0; r < 4; ++r) { const int mm = m0 + r * NGW, m = mm < MT ? mm : m0;
#pragma unroll
            for (int k = 0; k < 4; ++k) yw[r][k] = *(const u32x4*)(ys + ((size_t)m * 4 + k) * DM + c0);
            xw[r][0] = *(const u32x4*)(xmid + (size_t)m * DM + c0); xw[r][1] = *(const u32x4*)(xmid + (size_t)m * DM + c0 + 8); }
#pragma unroll
        for (int r = 0; r < 4; ++r) { const int m = m0 + r * NGW, b = (m < MT ? m : m0) / SEQ;
            float y[16];
#pragma unroll
            for (int i = 0; i < 16; ++i) y[i] = 0.f;
#pragma unroll
            for (int k = 0; k < 4; ++k)
#pragma unroll
                for (int d = 0; d < 4; ++d) { const int w = (int)yw[r][k][d]; const f32x2 lo = __builtin_amdgcn_cvt_pk_f32_fp8(w, false), hi = __builtin_amdgcn_cvt_pk_f32_fp8(w, true);
                    y[4 * d] += lo.x; y[4 * d + 1] += lo.y; y[4 * d + 2] += hi.x; y[4 * d + 3] += hi.y; }
            float v[16]; float ss = 0.f;
#pragma unroll
            for (int j = 0; j < 4; ++j) { const f32x4 g2 = *(const LAS f32x4*)(G2 + b * 1024 + c0 + 4 * j);
#pragma unroll
                for (int t = 0; t < 4; ++t) { const int i = 4 * j + t; const unsigned w = xw[r][i >> 3][(i >> 1) & 3]; const float xv = (i & 1) ? bfhi(w) : bflo(w);
                    v[i] = xv + g2[t] * (y[i] * (1.0f / YS_SCALE)); ss += v[i] * v[i]; } }
            const float rstd = rsqrtf(wave_sum(ss) * (1.0f / DM) + EPS);
            if (m < MT) { f32x4* orow = (f32x4*)(a.out + (size_t)m * DM + c0);
#pragma unroll
                for (int j = 0; j < 4; ++j) orow[j] = (f32x4){v[4 * j] * rstd * fg[j].x, v[4 * j + 1] * rstd * fg[j].y, v[4 * j + 2] * rstd * fg[j].z, v[4 * j + 3] * rstd * fg[j].w}; } }
    }
}

constexpr int NPH = 11;
__global__ void __launch_bounds__(512, 2) mk_fwd(Args a) {
    extern __shared__ __attribute__((aligned(16))) unsigned char lds_raw[];
    LAS unsigned char* lds = (LAS unsigned char*)lds_raw;
    volatile LAS unsigned* MISC = (volatile LAS unsigned*)(lds + LDSCTL_OFF);
    const int tid = threadIdx.x, lane = tid & 63, wave = __builtin_amdgcn_readfirstlane(tid >> 6);
    const int G = gridDim.x; const int bx = blockIdx.x; const int vcu = (G % 8 == 0) ? (bx % 8) * (G / 8) + bx / 8 : bx;
    for (int u = tid; u < (LDS_BYTES - LDSCTL_OFF) / 4; u += 512) MISC[u] = 0u;
    __syncthreads();
    unsigned* ctl = (unsigned*)(a.ws + WS_CTL);
    const int lo = a.ph_lo, hi = a.ph_hi;
    const bool multi = (hi - lo) > 1;
    XcdBarrier bar; bar.bar = ctl + CW_BAR; bar.x = 0; bar.st = nullptr;
    if (multi) bar = xcd_barrier_post(ctl + CW_BAR, MISC + MISC_BAR);
#ifndef PH_MASK
#define PH_MASK 0xFFFF
#endif
#define IN(k) (((PH_MASK >> (k)) & 1) && lo <= (k) && (k) < hi)
#define SEAM(k) do { if (IN(k) && IN((k) + 1)) xcd_barrier(bar); } while (0)
    unsigned char* ws = a.ws;

#ifndef REP_MASK
#define REP_MASK 0
#endif
#ifndef AMP_MASK
#define AMP_MASK 0
#endif
#define PHASE(k, ...) do { if (IN(k)) { const unsigned long long _t0 = ((AMP_MASK >> (k)) & 1) ? __builtin_amdgcn_s_memrealtime() : 0ull; \
        for (int _r = 0; _r <= ((REP_MASK >> (k)) & 1); ++_r) { if (_r) xcd_barrier(bar); __VA_ARGS__ } \
        if ((AMP_MASK >> (k)) & 1) { asm volatile("s_waitcnt vmcnt(0)" ::: "memory"); __syncthreads(); const unsigned long long _t1 = __builtin_amdgcn_s_memrealtime(); while (__builtin_amdgcn_s_memrealtime() - _t1 < 3ull * (_t1 - _t0)) __builtin_amdgcn_s_sleep(8); } } SEAM(k); } while (0)
    PHASE(0, { p0_prologue(a, lds, vcu, G, tid, wave, lane); p1_h1(a, vcu, G, tid, wave, lane); });
    PHASE(2, {
        pg8::DenseSched S; S.init((const bf16*)(ws + WS_H), (const bf16*)(ws + WS_WIN), MT, NIN, DM, G, bx);
        EpiZ E{(bf16*)(ws + WS_Z), (const float*)(ws + WS_LB)};
        pg8::gemm_phase<EpiZ, pg8::DenseSched>(lds, S, E); });
    PHASE(3, {
        hgrnA_phase(a, lds, bx, G, wave, lane);
        for (int it = 1024 + bx; it < 1536; it += G) gmlp_unit(a, lds, it - 1024, tid, wave, lane, XI_P3 + it * 8 + wave); });
    PHASE(4, hgrnB_scan((bf16*)(ws + WS_KV), (bf16*)(ws + (_r ? WS_OH : WS_KV)), (const float*)(ws + WS_DEC), bx * 512 + tid, G * 512););
    PHASE(5, hgrnC_phase(a, lds, bx, G, wave, lane););
    PHASE(6, {
        pg8::DenseSched S; S.init((const bf16*)(ws + WS_YMIX), (const bf16*)(ws + WS_WOUT), MT, DM, DM, G, bx);
        EpiXmid E{a.in[I_XIN], (bf16*)(ws + WS_XMID), (const float*)(ws + WS_MOD)};
        pg8::gemm_phase<EpiXmid, pg8::DenseSched>(lds, S, E); });
    PHASE(7, {
        const bool x32 = (G % 32) == 0; const int sub = x32 ? (bx >> 3) & 3 : bx & 3, role = sub == 3 ? 1 : 0, NR = G / 4, NC = G - NR;
        const int ridx = role ? (x32 ? (bx >> 5) * 8 + (bx & 7) : bx >> 2) : (x32 ? (bx >> 5) * 24 + sub * 8 + (bx & 7) : (bx >> 2) * 3 + sub);
        if (role == 0) { const int gw7 = ridx * 8 + wave, NGW7 = NC * 8; f32x4 ca[16], cb[16];
          if (gw7 < 16384) xcvt_load(a, gw7, lane, ca);
          for (int it = gw7; it < 16384; it += 2 * NGW7) {
              if (it + NGW7 < 16384) xcvt_load(a, it + NGW7, lane, cb);
              xcvt_store(a, it, lane, ca);
              if (it + 2 * NGW7 < 16384) xcvt_load(a, it + 2 * NGW7, lane, ca);
              if (it + NGW7 < 16384) xcvt_store(a, it + NGW7, lane, cb); } }
        else p6_router(a, lds, ridx, NR, tid, wave, lane, _r != 0); });
    PHASE(8, {
        moe_table(a, MISC, wave, lane);
        pg8::MoeSched<true> S; S.A = (const bf16*)(ws + WS_H); S.W = (const bf16*)(ws + WS_WGU); S.K = DM; S.NT = 8; S.lists = (const int*)(ws + WS_LISTS);
        S.tab = (const LAS int*)(MISC + MOE_TAB); S.G = G; S.c = bx; S.U = (int)MISC[MOE_TAB + 64] * 8;
        EpiAct E{(bf16*)(ws + WS_ACT), a.in[I_BGU]};
        pg8::gemm_phase<EpiAct, pg8::MoeSched<true>>(lds, S, E); });
    PHASE(9, {
        moe_table(a, MISC, wave, lane);
        pg8::MoeSched<false> S; S.A = (const bf16*)(ws + WS_ACT); S.W = (const bf16*)(ws + WS_WD); S.K = DFF; S.NT = 4; S.lists = (const int*)(ws + WS_LISTS);
        S.tab = (const LAS int*)(MISC + MOE_TAB); S.G = G; S.c = bx; S.U = (int)MISC[MOE_TAB + 64] * 4;
        EpiDown E{(unsigned char*)(ws + WS_YSLOT), a.in[I_BD], (const float*)(ws + WS_LGATE), (const int*)(ws + WS_LISTS)};
        pg8::gemm_phase<EpiDown, pg8::MoeSched<false>>(lds, S, E); });
    PHASE(10, p9_final(a, lds, vcu, G, tid, wave, lane););
#undef PHASE
#undef IN
#undef SEAM
}

extern "C" void kernel_launch(void* const* d_in, const int* in_sizes, int n_in, void* d_out, int out_size, void* d_ws, size_t ws_size, hipStream_t stream) {
    static int grid = 0;
    if (grid == 0) {
        if (n_in != 22 || in_sizes[0] != MT * DM || out_size != MT * DM || ws_size < WS_END) { fprintf(stderr, "kernel_launch: unexpected shapes (n_in %d, in0 %d, out %d, ws %zu)\n", n_in, n_in > 0 ? in_sizes[0] : -1, out_size, ws_size); grid = -1; return; }
        int dev = 0, cus = 0, per_cu = 0;
        if (hipGetDevice(&dev) != hipSuccess || hipDeviceGetAttribute(&cus, hipDeviceAttributeMultiprocessorCount, dev) != hipSuccess) { grid = -1; return; }
        if (hipFuncSetAttribute((const void*)mk_fwd, hipFuncAttributeMaxDynamicSharedMemorySize, LDS_BYTES) != hipSuccess) { fprintf(stderr, "kernel_launch: hipFuncSetAttribute failed\n"); grid = -1; return; }
        if (hipOccupancyMaxActiveBlocksPerMultiprocessor(&per_cu, (const void*)mk_fwd, 512, LDS_BYTES) != hipSuccess || per_cu < 1) fprintf(stderr, "kernel_launch: occupancy query says %d\n", per_cu);
        (void)hipGetLastError();
        grid = cus;
    }
    if (grid < 0) return;
    (void)hipMemsetAsync((char*)d_ws + WS_CTL, 0, CTL_ZERO_BYTES, stream);
    Args a{};
    for (int i = 0; i < 22; ++i) a.in[i] = (const float*)d_in[i];
    a.out = (float*)d_out; a.ws = (unsigned char*)d_ws;
    auto run = [&](int lo, int hi) { a.ph_lo = lo; a.ph_hi = hi; hipLaunchKernelGGL(mk_fwd, dim3(grid), dim3(512), LDS_BYTES, stream, a); };
    run(0, NPH);
}
```

```cpp
#include <hip/hip_runtime.h>
#include <cstdio>
#include <cstdint>

#define GAS __attribute__((address_space(1)))
#define LAS __attribute__((address_space(3)))
typedef unsigned short bf16;
typedef unsigned u32x4 __attribute__((ext_vector_type(4)));
typedef unsigned u32x2 __attribute__((ext_vector_type(2)));
typedef float f32x4 __attribute__((ext_vector_type(4)));
typedef float f32x2 __attribute__((ext_vector_type(2)));
typedef short bf16x8 __attribute__((ext_vector_type(8)));
typedef long v2i64 __attribute__((ext_vector_type(2)));
typedef int v4i32 __attribute__((ext_vector_type(4)));
typedef int v8i32 __attribute__((ext_vector_type(8)));
typedef __bf16 bf16x2_t __attribute__((ext_vector_type(2)));

constexpr int DM = 1024, NB = 4, SEQ = 4096, MT = NB * SEQ;
constexpr int HW = 512, NH = 4, HD = 128, HCH = 64;
constexpr int GW = 512, GG = 4, GD = 128, GCH = 128;
constexpr int NIN = 3072, NE = 32, TOPK = 4, DFF = 1024;
constexpr int NSLOT = MT * TOPK;
constexpr int LSTRIDE = MT;
constexpr float EPS = 1e-6f;
constexpr float SW_LIMIT = 7.0f, SW_ALPHA = 1.702f;
constexpr float WGU_SCALE = 64.0f, H2_SCALE = 8.0f;
constexpr float WD_SCALE = 64.0f, ACT_SCALE = 8.0f;
constexpr float YS_SCALE = 8.0f;

constexpr size_t MiB = 1u << 20;
constexpr size_t WS_CTL = 0, CTL_ZERO_BYTES = 64 * 1024;
constexpr size_t WS_MOD = 1 * MiB;
constexpr size_t WS_LB = 1 * MiB + 128 * 1024;
constexpr size_t WS_SB = 1 * MiB + 136 * 1024;
constexpr size_t WS_SA = 1 * MiB + 192 * 1024;
constexpr size_t WS_WRH = 1 * MiB + 256 * 1024;
constexpr size_t WS_WRL = 1 * MiB + 384 * 1024;
constexpr size_t WS_GWS = 1 * MiB + 512 * 1024;
constexpr size_t WS_WIN = 2 * MiB;
constexpr size_t WS_WOUT = 8 * MiB;
constexpr size_t WS_WGU = 16 * MiB;
constexpr size_t WS_WD = 144 * MiB;
constexpr size_t WS_H = 208 * MiB;
constexpr size_t WS_Z = 240 * MiB;
constexpr size_t WS_YMIX = 336 * MiB;
constexpr size_t WS_XMID = 368 * MiB;
constexpr size_t WS_KV = 432 * MiB;
constexpr size_t WS_DEC = 496 * MiB;
constexpr size_t WS_GATES = 497 * MiB;
constexpr size_t WS_LISTS = 498 * MiB;
constexpr size_t WS_LGATE = 502 * MiB;
constexpr size_t WS_ACT = 512 * MiB;
constexpr size_t WS_YSLOT = 656 * MiB;
constexpr size_t WS_OH = 784 * MiB;
constexpr size_t WS_VLN = 816 * MiB;
constexpr size_t WS_YG = 848 * MiB;
constexpr size_t WS_END = 880 * MiB;
constexpr int CW_TMO = 0, CW_CODE = 1, CW_MODRDY = 64;
constexpr int CW_BAR = 1024;
constexpr int CW_CNT = 8192, CNT_STRIDE = 64;
static_assert((CW_CNT + CNT_STRIDE * 32) * 4 <= (int)CTL_ZERO_BYTES, "ctl");

constexpr int LDS_BYTES = 163840;
constexpr int LDSCTL_OFF = 162816;
constexpr int MISC_BAR = 8;
constexpr int MOE_TAB = 64;
constexpr int AUX_OFF = 131072;

__device__ __forceinline__ float bf2f(unsigned short b) { return __uint_as_float(((unsigned)b) << 16); }
__device__ __forceinline__ unsigned pk2(float lo, float hi) { f32x2 v = {lo, hi}; bf16x2_t b = __builtin_convertvector(v, bf16x2_t); return __builtin_bit_cast(unsigned, b); }
__device__ __forceinline__ float bflo(unsigned w) { return __uint_as_float(w << 16); }
__device__ __forceinline__ float bfhi(unsigned w) { return __uint_as_float(w & 0xffff0000u); }
__device__ __forceinline__ float wave_sum(float v) {
#pragma unroll
    for (int o = 1; o < 64; o <<= 1) v += __shfl_xor(v, o);
    return v;
}
template <int CTRL> __device__ __forceinline__ float dpp_f(float v) { return __builtin_bit_cast(float, __builtin_amdgcn_update_dpp(0, __builtin_bit_cast(int, v), CTRL, 0xf, 0xf, true)); }
__device__ __forceinline__ float lane_xor1(float v) { return dpp_f<0xB1>(v); }
__device__ __forceinline__ float lane_xor2(float v) { return dpp_f<0x4E>(v); }
__device__ __forceinline__ float row16_sum(float s) { s += dpp_f<0x128>(s); s += dpp_f<0x124>(s); s += lane_xor2(s); s += lane_xor1(s); return s; }
__device__ __forceinline__ void lds_barrier() { asm volatile("s_waitcnt lgkmcnt(0)" ::: "memory"); __builtin_amdgcn_s_barrier(); asm volatile("" ::: "memory"); }
__device__ __forceinline__ float fsigmoid(float z) { return __builtin_amdgcn_rcpf(1.0f + __builtin_amdgcn_exp2f(z * -1.4426950408889634f)); }
__device__ __forceinline__ f32x2 gelu_pk(f32x2 v) {
    const f32x2 av = __builtin_elementwise_abs(v), d = av * 0.2316418882f + 1.0f;
    f32x2 t; t.x = __builtin_amdgcn_rcpf(d.x); t.y = __builtin_amdgcn_rcpf(d.y);
    f32x2 q = t * 0.5307027145f + (-0.7265760135f); q = q * t + 0.7107068705f; q = q * t + (-0.142248368f); q = q * t + 0.127414796f; q = q * t;
    const f32x2 s = (v * v) * (-0.72134752044f);
    f32x2 e; e.x = __builtin_amdgcn_exp2f(s.x); e.y = __builtin_amdgcn_exp2f(s.y);
    const f32x2 m = v * (q * e), r = v - m;
    f32x2 o; o.x = v.x < 0.f ? m.x : r.x; o.y = v.y < 0.f ? m.y : r.y; return o;
}
__device__ __forceinline__ bf16x8 mk_frag(unsigned a, unsigned b, unsigned c, unsigned d) { u32x4 w = {a, b, c, d}; return __builtin_bit_cast(bf16x8, w); }
__device__ __forceinline__ float gelu1(float x) { f32x2 r = gelu_pk((f32x2){x, x}); return r.x; }

namespace pg8 {
constexpr int BM = 256, BK = 64, HALF = 128, HTB = HALF * BK * 2, STAGE_BYTES = 8 * HTB, NXCD = 8, WGM = 8;
__host__ __device__ __forceinline__ int lds_byte(int r, int c) { const int st = (r >> 4) * 2 + (c >> 5), rr = r & 15, cc = c & 31, ob = rr * 64 + cc * 2; return st * 1024 + (ob ^ (((ob >> 9) & 1) << 5)); }
__host__ __device__ __forceinline__ void stage_rc(int b, int& R, int& C) { const int st = b / 1024, sb = b % 1024, swz = sb ^ (((sb >> 9) & 1) << 5); R = (st >> 1) * 16 + swz / 64; C = (st & 1) * 32 + (swz % 64) / 2; }
__host__ __device__ __forceinline__ int perm32(int rho) { const int n = rho >> 4, i = rho & 15; return 8 * (i >> 2) + 4 * n + (i & 3); }

struct Unit { int pm, pn, e, rb, cnt; };

template <bool I8_> struct DenseSchedT {
    static constexpr bool GATHER = false, FP8 = false, I8 = I8_;
    const bf16* A; const bf16* Bt; int K;
    int nM, nN, nwg, G, c;
    __device__ void init(const bf16* A_, const bf16* Bt_, int M, int N, int K_, int G_, int c_) { A = A_; Bt = Bt_; K = K_; nM = M / BM; nN = N / BM; nwg = nM * nN; G = G_; c = c_; }
    __device__ __forceinline__ bool next(int i, Unit& u) const {
        const long L = (long)i * G + c; if (L >= nwg) return false;
        int wgid = (int)L; { const int q = nwg / NXCD, r = nwg % NXCD, xcd = wgid % NXCD, off = wgid / NXCD; wgid = (xcd < r ? xcd * (q + 1) : r * (q + 1) + (xcd - r) * q) + off; }
        const int nig = WGM * nN, gid = wgid / nig, fm = gid * WGM, gsz = (nM - fm) < WGM ? (nM - fm) : WGM;
        u.pm = fm + ((wgid % nig) % gsz); u.pn = (wgid % nig) / gsz; u.e = 0; u.rb = 0; u.cnt = 256; return true;
    }
    __device__ __forceinline__ const char* a_ptr(const Unit& u) const { return (const char*)A + (size_t)u.pm * (size_t)(2 * HALF) * K * 2; }
    __device__ __forceinline__ const char* b_ptr(const Unit& u) const { return (const char*)Bt + (size_t)u.pn * (size_t)(2 * HALF) * K * 2; }
    __device__ __forceinline__ void gather_off(const Unit&, int, const LAS unsigned char*, int, unsigned (&)[2][2]) const {}
    __device__ __forceinline__ void prefetch_rows(LAS unsigned char*, int) const {}
};
typedef DenseSchedT<false> DenseSched;
template <bool GATH> struct MoeSched {
    static constexpr bool GATHER = GATH, FP8 = true, I8 = false;
    const bf16* A; const bf16* W; int K; int NT;
    const int* lists; const LAS int* tab; int G, c, U, lo;
    __device__ __forceinline__ bool next(int i, Unit& u) const {
        const long L = (long)i * G + c; if (L >= U) return false;
        int wgid = (int)L; { const int q = U / NXCD, r = U % NXCD, xcd = wgid % NXCD, off = wgid / NXCD; wgid = (xcd < r ? xcd * (q + 1) : r * (q + 1) + (xcd - r) * q) + off; }
        wgid += lo;
        const int ln = threadIdx.x & 63; const int pre = tab[32 + (ln & 31)] * NT;
        const unsigned long long mk = __ballot(ln < 32 && pre <= wgid);
        const int e = 63 - __builtin_clzll(mk | 1ull);
        const int rb0 = tab[32 + e], nb = tab[32 + e + 1] - rb0, j = wgid - rb0 * NT;
        u.e = e; u.pn = j / nb; u.rb = j % nb; u.pm = rb0 + u.rb; u.cnt = tab[e] - u.rb * 256; return true;
    }
    __device__ __forceinline__ const char* a_ptr(const Unit& u) const { return GATH ? (const char*)A : (const char*)A + (size_t)u.pm * (size_t)(2 * HALF) * K * 2; }
    __device__ __forceinline__ const char* b_ptr(const Unit& u) const { return (const char*)W + ((size_t)u.e * NT + u.pn) * (size_t)(2 * HALF) * K * 2; }
    __device__ __forceinline__ void prefetch_rows(LAS unsigned char* auxr, int tid) const {
        int tmp[9]; Unit u;
#pragma unroll
        for (int i = 0; i < 9; ++i) { tmp[i] = 0; if (tid < 256 && next(i, u)) { const int rc = tid < u.cnt ? tid : u.cnt - 1; tmp[i] = lists[(size_t)u.e * LSTRIDE + u.rb * 256 + rc] >> 2; } }
        if (tid < 256) {
#pragma unroll
            for (int i = 0; i < 9; ++i) ((LAS int*)auxr)[i * 256 + tid] = tmp[i]; }
    }
    __device__ __forceinline__ void gather_off(const Unit& u, int ui, const LAS unsigned char* auxr, int tid, unsigned (&v)[2][2]) const {
#pragma unroll
        for (int i = 0; i < 2; ++i) { int R, C; stage_rc(tid * 16 + i * 8192, R, C);
#pragma unroll
            for (int h = 0; h < 2; ++h) { const int tok = ((const LAS int*)auxr)[ui * 256 + R + 128 * h]; v[h][i] = (unsigned)tok * (unsigned)(K * 2) + (unsigned)(C * 2); } }
    }
};

template <class Epi, class Sched>
__device__ __forceinline__ void gemm_phase(LAS unsigned char* lds, const Sched& S, const Epi& E) {
    const int tid = threadIdx.x, wid = __builtin_amdgcn_readfirstlane(tid >> 6), lane = tid & 63, wr = wid >> 2, wc = wid & 3, fr = lane & 15, fq = lane >> 4;
    const int K = S.K, nt = K / BK;
    unsigned voffA[2], voffB[2];
#pragma unroll
    for (int i = 0; i < 2; ++i) { int R, C; stage_rc(tid * 16 + i * 8192, R, C); const int Rb = Epi::PERM ? ((R & ~31) + perm32(R & 31)) : R;
        voffA[i] = (unsigned)(R * K + C) * 2u; voffB[i] = (unsigned)(Rb * K + C) * 2u; }
    const size_t kstep = (size_t)(BK * 2);
    const size_t hstep = (size_t)HALF * K * 2;
    const unsigned ldsw = (unsigned)wid * 1024u;
    const int aoff = lds_byte(wr * 64 + fr, fq * 8), boff = lds_byte(wc * 32 + fr, fq * 8);
#define PG8_SA(b, h) (((b) * 2 + (h)) * HTB)
#define PG8_SB(b, h) ((4 + (b) * 2 + (h)) * HTB)
#define PG8_GLDS(gp, off) __builtin_amdgcn_global_load_lds((const unsigned*)(gp), (LAS unsigned*)(lds + (off)), 16, 0, 0)
#define PG8_STAGE_B(bufoff, gbase) do { _Pragma("unroll") for (int _i = 0; _i < 2; ++_i) PG8_GLDS((const char*)(gbase) + voffB[_i], (bufoff) + ldsw + _i * 8192); } while (0)
#define PG8_STAGE_A(bufoff, h, kp) do { if constexpr (Sched::GATHER) { _Pragma("unroll") for (int _i = 0; _i < 2; ++_i) PG8_GLDS((const char*)(kp) + vAc[h][_i], (bufoff) + ldsw + _i * 8192); } \
        else { _Pragma("unroll") for (int _i = 0; _i < 2; ++_i) PG8_GLDS((const char*)(kp) + (h) * hstep + voffA[_i], (bufoff) + ldsw + _i * 8192); } } while (0)
#define PG8_LD8(p_) ({ const u32x4 _lo = *(const LAS u32x4*)(p_), _hi = *(const LAS u32x4*)((p_) + 1024); (v8i32){(int)_lo.x, (int)_lo.y, (int)_lo.z, (int)_lo.w, (int)_hi.x, (int)_hi.y, (int)_hi.z, (int)_hi.w}; })
#define PG8_LDA(dst, b, h) do { if constexpr (Sched::FP8) { _Pragma("unroll") for (int m = 0; m < 4; ++m) dst##8[m] = PG8_LD8(lds + PG8_SA(b, h) + aoff + m * 2048); } \
        else { _Pragma("unroll") for (int m = 0; m < 4; ++m) _Pragma("unroll") for (int k = 0; k < 2; ++k) dst[m][k] = *(const LAS bf16x8*)(lds + PG8_SA(b, h) + aoff + m * 2048 + k * 1024); } } while (0)
#define PG8_LDB(dst, b, h) do { if constexpr (Sched::FP8) { _Pragma("unroll") for (int n = 0; n < 2; ++n) dst##8[n] = PG8_LD8(lds + PG8_SB(b, h) + boff + n * 2048); } \
        else { _Pragma("unroll") for (int n = 0; n < 2; ++n) _Pragma("unroll") for (int k = 0; k < 2; ++k) dst[n][k] = *(const LAS bf16x8*)(lds + PG8_SB(b, h) + boff + n * 2048 + k * 1024); } } while (0)
#define PG8_MMA(ai, bj, At, Bt) do { __builtin_amdgcn_s_setprio(1); _Pragma("unroll") for (int m = 0; m < 4; ++m) _Pragma("unroll") for (int n = 0; n < 2; ++n) { \
        if constexpr (Sched::FP8) asm volatile("v_mfma_scale_f32_16x16x128_f8f6f4 %0, %1, %2, %0, %3, %3 op_sel_hi:[0,0,0]" : "+v"(acc[ai][bj][m][n]) : "v"(Bt##8[n]), "v"(At##8[m]), "v"(sc1)); \
        else if constexpr (Sched::I8) { _Pragma("unroll") for (int k = 0; k < 2; ++k) acc[ai][bj][m][n] = __builtin_bit_cast(f32x4, __builtin_amdgcn_mfma_i32_16x16x64_i8(__builtin_bit_cast(v4i32, Bt[n][k]), __builtin_bit_cast(v4i32, At[m][k]), __builtin_bit_cast(v4i32, acc[ai][bj][m][n]), 0, 0, 0)); }     \
        else { _Pragma("unroll") for (int k = 0; k < 2; ++k) acc[ai][bj][m][n] = __builtin_amdgcn_mfma_f32_16x16x32_bf16(Bt[n][k], At[m][k], acc[ai][bj][m][n], 0, 0, 0); } } \
        __builtin_amdgcn_s_setprio(0); } while (0)
#define PG8_WAIT_V(n) asm volatile("s_waitcnt vmcnt(" #n ")" ::: "memory")
#define PG8_WAIT_L(n) asm volatile("s_waitcnt lgkmcnt(" #n ")" ::: "memory")
#define PG8_BAR __builtin_amdgcn_s_barrier()
#define PG8_SCHED __builtin_amdgcn_sched_barrier(0)
    Unit cur, nxt; int ui = 0;
    if constexpr (Sched::GATHER) S.prefetch_rows(lds + AUX_OFF + 16384, tid);
    if constexpr (Epi::LDSPRE || Sched::GATHER) { if constexpr (Epi::LDSPRE) E.prefetch(S, lds + AUX_OFF, tid); asm volatile("s_waitcnt lgkmcnt(0)" ::: "memory"); __builtin_amdgcn_s_barrier(); asm volatile("" ::: "memory"); }
    if (!S.next(0, cur)) return;
    f32x4 acc[2][2][4][2];
#pragma unroll
    for (int a = 0; a < 2; ++a)
#pragma unroll
        for (int b = 0; b < 2; ++b)
#pragma unroll
            for (int m = 0; m < 4; ++m)
#pragma unroll
                for (int n = 0; n < 2; ++n) acc[a][b][m][n] = (f32x4){0.f, 0.f, 0.f, 0.f};
    bf16x8 At[4][2], B0[2][2], B1[2][2];
    v8i32 At8[4], B08[2], B18[2]; int sc1 = 0x7f7f7f7f;
    unsigned vAc[2][2] = {{0u, 0u}, {0u, 0u}};
    if constexpr (Sched::GATHER) { S.gather_off(cur, 0, lds + AUX_OFF + 16384, tid, vAc); }
    const char* cA = S.a_ptr(cur); const char* cB = S.b_ptr(cur);
    PG8_STAGE_B(PG8_SB(0, 0), cB); PG8_STAGE_B(PG8_SB(0, 1), cB + hstep); PG8_STAGE_A(PG8_SA(0, 0), 0, cA); PG8_STAGE_A(PG8_SA(0, 1), 1, cA);
    if (wr == 1) PG8_BAR;
    PG8_WAIT_V(2); PG8_BAR;
    PG8_STAGE_B(PG8_SB(1, 0), cB + kstep); PG8_STAGE_A(PG8_SA(1, 0), 0, cA + kstep); PG8_STAGE_B(PG8_SB(1, 1), cB + hstep + kstep);
    PG8_WAIT_V(6); PG8_BAR;
    for (;;) {
        const bool has_next = S.next(ui + 1, nxt);
        const char* nA = has_next ? S.a_ptr(nxt) : cA; const char* nB = has_next ? S.b_ptr(nxt) : cB;
        for (int t = 0; t < nt; t += 2) {
            const bool last = (t == nt - 2);
            const char* a1 = cA + (size_t)(t + 1) * kstep;
            const char* a2 = last ? nA : cA + (size_t)(t + 2) * kstep; const char* b2 = last ? nB : cB + (size_t)(t + 2) * kstep;
            const char* a3 = a2 + kstep; const char* b3 = b2 + kstep;
            PG8_LDB(B0, 0, 0); PG8_LDB(B1, 0, 1); PG8_SCHED; PG8_LDA(At, 0, 0); PG8_STAGE_A(PG8_SA(1, 1), 1, a1);
            if constexpr (Sched::GATHER) { if (last && has_next) S.gather_off(nxt, ui + 1, lds + AUX_OFF + 16384, tid, vAc); }
            PG8_WAIT_V(8); PG8_WAIT_L(0); PG8_BAR; PG8_MMA(0, 0, At, B0); PG8_MMA(0, 1, At, B1); PG8_BAR; PG8_SCHED;
            PG8_LDA(At, 0, 1); PG8_STAGE_B(PG8_SB(0, 0), b2); PG8_STAGE_B(PG8_SB(0, 1), b2 + hstep); PG8_STAGE_A(PG8_SA(0, 0), 0, a2);
            PG8_WAIT_V(8); PG8_WAIT_L(0); PG8_BAR; PG8_MMA(1, 0, At, B0); PG8_MMA(1, 1, At, B1); PG8_BAR; PG8_SCHED;
            PG8_LDB(B0, 1, 0); PG8_LDB(B1, 1, 1); PG8_SCHED; PG8_LDA(At, 1, 0); PG8_STAGE_A(PG8_SA(0, 1), 1, a2);
            PG8_WAIT_V(8); PG8_WAIT_L(0); PG8_BAR; PG8_MMA(0, 0, At, B0); PG8_MMA(0, 1, At, B1); PG8_BAR; PG8_SCHED;
            PG8_LDA(At, 1, 1); PG8_STAGE_B(PG8_SB(1, 0), b3); PG8_STAGE_B(PG8_SB(1, 1), b3 + hstep); PG8_STAGE_A(PG8_SA(1, 0), 0, a3);
            PG8_WAIT_V(8); PG8_WAIT_L(0); PG8_BAR; PG8_MMA(1, 0, At, B0); PG8_MMA(1, 1, At, B1); PG8_BAR; PG8_SCHED;
        }
        if (wr == 0) PG8_BAR;
        if constexpr (Sched::FP8) asm volatile("s_nop 11" ::: "memory");
        E(acc, cur, wr, wc, fr, fq, ui, lds + AUX_OFF);
        if (!has_next) break;
#pragma unroll
        for (int a = 0; a < 2; ++a)
#pragma unroll
            for (int b = 0; b < 2; ++b)
#pragma unroll
                for (int m = 0; m < 4; ++m)
#pragma unroll
                    for (int n = 0; n < 2; ++n) acc[a][b][m][n] = (f32x4){0.f, 0.f, 0.f, 0.f};
        cur = nxt; cA = nA; cB = nB; ++ui;
        if (wr == 1) PG8_BAR;
    }
    PG8_WAIT_V(0);
    PG8_BAR;
#undef PG8_SA
#undef PG8_SB
#undef PG8_GLDS
#undef PG8_STAGE_A
#undef PG8_STAGE_B
#undef PG8_LDA
#undef PG8_LD8
#undef PG8_LDB
#undef PG8_MMA
#undef PG8_WAIT_V
#undef PG8_WAIT_L
#undef PG8_BAR
#undef PG8_SCHED
}
}

struct EpiZ {
    static constexpr bool PERM = true, LDSPRE = false;
    template <class Sched> __device__ __forceinline__ void prefetch(const Sched&, LAS unsigned char*, int) const {}
    bf16* Z; const float* lb; const float* sa; const float* sb;
    __device__ __forceinline__ void operator()(const f32x4 (&acc)[2][2][4][2], const pg8::Unit& u, int wr, int wc, int fr, int fq, int ui, const LAS unsigned char* aux) const {
        const int row0 = u.pm * 256 + wr * 64 + fr, seg = u.pn >> 1, col0 = u.pn * 256 + wc * 32 + 8 * fq;
        f32x4 lbv[2][2];
#pragma unroll
        for (int bj = 0; bj < 2; ++bj)
#pragma unroll
            for (int n = 0; n < 2; ++n) lbv[bj][n] = (seg == 1) ? *(const f32x4*)(lb + (col0 - 512) + bj * 128 + 4 * n) : (f32x4){0.f, 0.f, 0.f, 0.f};
        f32x4 sbv[2][2];
#pragma unroll
        for (int bj = 0; bj < 2; ++bj)
#pragma unroll
            for (int n = 0; n < 2; ++n) sbv[bj][n] = *(const f32x4*)(sb + col0 + bj * 128 + 4 * n);
#pragma unroll
        for (int ai = 0; ai < 2; ++ai)
#pragma unroll
            for (int m = 0; m < 4; ++m) { bf16* rowp = Z + (size_t)(row0 + ai * 128 + m * 16) * NIN + col0; const float sar = sa[row0 + ai * 128 + m * 16];
#pragma unroll
                for (int bj = 0; bj < 2; ++bj) { f32x4 v0 = __builtin_convertvector(__builtin_bit_cast(v4i32, acc[ai][bj][m][0]), f32x4) * (sbv[bj][0] * sar), v1 = __builtin_convertvector(__builtin_bit_cast(v4i32, acc[ai][bj][m][1]), f32x4) * (sbv[bj][1] * sar);
                    if (seg == 1) {
#pragma unroll
                        for (int j = 0; j < 4; ++j) { const float l0 = lbv[bj][0][j], l1 = lbv[bj][1][j];
                            v0[j] = __builtin_amdgcn_logf(l0 + (1.0f - l0) * fsigmoid(v0[j])); v1[j] = __builtin_amdgcn_logf(l1 + (1.0f - l1) * fsigmoid(v1[j])); }
                    } else if (seg == 3) {
#pragma unroll
                        for (int j = 0; j < 4; ++j) { v0[j] = v0[j] * fsigmoid(v0[j]); v1[j] = v1[j] * fsigmoid(v1[j]); }
                    } else if (seg >= 4) {
                        f32x2 a = gelu_pk((f32x2){v0[0], v0[1]}), b = gelu_pk((f32x2){v0[2], v0[3]}), c = gelu_pk((f32x2){v1[0], v1[1]}), d = gelu_pk((f32x2){v1[2], v1[3]});
                        v0 = (f32x4){a.x, a.y, b.x, b.y}; v1 = (f32x4){c.x, c.y, d.x, d.y};
                    }
                    u32x4 w; w.x = pk2(v0[0], v0[1]); w.y = pk2(v0[2], v0[3]); w.z = pk2(v1[0], v1[1]); w.w = pk2(v1[2], v1[3]);
                    *(u32x4*)(rowp + bj * 128) = w; } }
    }
};
struct EpiXmid {
    static constexpr bool PERM = true, LDSPRE = false;
    template <class Sched> __device__ __forceinline__ void prefetch(const Sched&, LAS unsigned char*, int) const {}
    const float* x; bf16* xmid; const float* mod;
    __device__ __forceinline__ void operator()(const f32x4 (&acc)[2][2][4][2], const pg8::Unit& u, int wr, int wc, int fr, int fq, int ui, const LAS unsigned char* aux) const {
        const int row0 = u.pm * 256 + wr * 64 + fr, col0 = u.pn * 256 + wc * 32 + 8 * fq, b = (u.pm * 256) / SEQ;
        f32x4 gv[2][2];
#pragma unroll
        for (int bj = 0; bj < 2; ++bj)
#pragma unroll
            for (int n = 0; n < 2; ++n) gv[bj][n] = *(const f32x4*)(mod + b * 6144 + 2048 + col0 + bj * 128 + 4 * n);
#pragma unroll
        for (int ai = 0; ai < 2; ++ai)
#pragma unroll
            for (int mp = 0; mp < 2; ++mp) {
                f32x4 xv[2][2][2];
#pragma unroll
                for (int mm = 0; mm < 2; ++mm) { const size_t off = (size_t)(row0 + ai * 128 + (2 * mp + mm) * 16) * DM + col0;
#pragma unroll
                    for (int bj = 0; bj < 2; ++bj)
#pragma unroll
                        for (int n = 0; n < 2; ++n) xv[mm][bj][n] = *(const f32x4*)(x + off + bj * 128 + 4 * n); }
#pragma unroll
                for (int mm = 0; mm < 2; ++mm) { const int m = 2 * mp + mm; const size_t off = (size_t)(row0 + ai * 128 + m * 16) * DM + col0;
#pragma unroll
                    for (int bj = 0; bj < 2; ++bj) { const f32x4 v0 = xv[mm][bj][0] + gv[bj][0] * acc[ai][bj][m][0], v1 = xv[mm][bj][1] + gv[bj][1] * acc[ai][bj][m][1];
                        u32x4 w; w.x = pk2(v0[0], v0[1]); w.y = pk2(v0[2], v0[3]); w.z = pk2(v1[0], v1[1]); w.w = pk2(v1[2], v1[3]);
                        *(u32x4*)(xmid + off + bj * 128) = w; } } }
    }
};

struct EpiAct {
    static constexpr bool PERM = true, LDSPRE = true;
    template <class Sched> __device__ __forceinline__ void prefetch(const Sched& S, LAS unsigned char* aux, int tid) const {
        float tmp[9]; pg8::Unit u;
#pragma unroll
        for (int i = 0; i < 9; ++i) { tmp[i] = 0.f; if (tid < 256 && S.next(i, u)) tmp[i] = bgu[(size_t)u.e * 2048 + (tid >> 7) * 1024 + u.pn * 128 + (tid & 127)]; }
        if (tid < 256) {
#pragma unroll
            for (int i = 0; i < 9; ++i) ((LAS float*)aux)[i * 256 + tid] = tmp[i]; }
    }
    bf16* act; const float* bgu;
    __device__ __forceinline__ void operator()(const f32x4 (&acc)[2][2][4][2], const pg8::Unit& u, int wr, int wc, int fr, int fq, int ui, const LAS unsigned char* aux) const {
        const int row0 = u.pm * 256 + wr * 64 + fr, c0 = u.pn * 128 + wc * 32 + 8 * fq;
        const LAS float* bg = (const LAS float*)aux + ui * 256 + wc * 32 + 8 * fq;
        constexpr float SC = 1.0f / (WGU_SCALE * H2_SCALE), UL = SW_LIMIT * ACT_SCALE;
        f32x2 bg2[2][2], bu2[2][2];
#pragma unroll
        for (int n = 0; n < 2; ++n) { const f32x4 tg = *(const LAS f32x4*)(bg + 4 * n), tu = *(const LAS f32x4*)(bg + 128 + 4 * n);
            bg2[n][0] = (f32x2){tg.x, tg.y}; bg2[n][1] = (f32x2){tg.z, tg.w}; bu2[n][0] = (f32x2){tu.x, tu.y} * ACT_SCALE; bu2[n][1] = (f32x2){tu.z, tu.w} * ACT_SCALE; }
#pragma unroll
        for (int ai = 0; ai < 2; ++ai)
#pragma unroll
            for (int m = 0; m < 4; ++m) { unsigned char* rowp = (unsigned char*)act + (size_t)(row0 + ai * 128 + m * 16) * DFF + c0;
                int w[2];
#pragma unroll
                for (int n = 0; n < 2; ++n) { f32x2 o2[2];
#pragma unroll
                    for (int jp = 0; jp < 2; ++jp) { const f32x2 ag = {acc[ai][0][m][n][2 * jp], acc[ai][0][m][n][2 * jp + 1]}, au = {acc[ai][1][m][n][2 * jp], acc[ai][1][m][n][2 * jp + 1]};
                        f32x2 g = ag * SC + bg2[n][jp], up = au * (SC * ACT_SCALE) + bu2[n][jp];
                        g.x = fminf(g.x, SW_LIMIT); g.y = fminf(g.y, SW_LIMIT); up.x = __builtin_amdgcn_fmed3f(up.x, -UL, UL); up.y = __builtin_amdgcn_fmed3f(up.y, -UL, UL);
                        f32x2 e = g * (-SW_ALPHA * 1.4426950408889634f); e.x = __builtin_amdgcn_exp2f(e.x); e.y = __builtin_amdgcn_exp2f(e.y);
                        f32x2 d = e + 1.0f; d.x = __builtin_amdgcn_rcpf(d.x); d.y = __builtin_amdgcn_rcpf(d.y);
                        o2[jp] = (g * d) * (up + ACT_SCALE); }
                    w[n] = __builtin_amdgcn_cvt_pk_fp8_f32(o2[0].x, o2[0].y, 0, false); w[n] = __builtin_amdgcn_cvt_pk_fp8_f32(o2[1].x, o2[1].y, w[n], true); }
                *(u32x2*)rowp = (u32x2){(unsigned)w[0], (unsigned)w[1]}; }
    }
};
struct EpiDown {
    static constexpr bool PERM = true, LDSPRE = true;
    template <class Sched> __device__ __forceinline__ void prefetch(const Sched& S, LAS unsigned char* aux, int tid) const {
        float tb[5]; int ts[5]; float tg[5]; pg8::Unit u;
#pragma unroll
        for (int i = 0; i < 5; ++i) { tb[i] = 0.f; ts[i] = 0; tg[i] = 0.f;
            if (S.next(i, u)) { if (tid < 256) tb[i] = bd[(size_t)u.e * DM + u.pn * 256 + tid];
                else { const int rl = tid - 256, rc = rl < u.cnt ? rl : u.cnt - 1; const size_t li = (size_t)u.e * LSTRIDE + u.rb * 256 + rc; ts[i] = lists[li]; tg[i] = lgate[li]; } } }
#pragma unroll
        for (int i = 0; i < 5; ++i) { if (tid < 256) ((LAS float*)aux)[i * 256 + tid] = tb[i]; else { ((LAS int*)(aux + 5120))[i * 256 + tid - 256] = ts[i]; ((LAS float*)(aux + 10240))[i * 256 + tid - 256] = tg[i]; } }
    }
    unsigned char* yslot; const float* bd; const float* lgate; const int* lists;
    __device__ __forceinline__ void operator()(const f32x4 (&acc)[2][2][4][2], const pg8::Unit& u, int wr, int wc, int fr, int fq, int ui, const LAS unsigned char* aux) const {
        const int rl0 = wr * 64 + fr, col0 = u.pn * 256 + wc * 32 + 8 * fq;
        f32x4 bv[2][2];
#pragma unroll
        for (int bj = 0; bj < 2; ++bj)
#pragma unroll
            for (int n = 0; n < 2; ++n) bv[bj][n] = *(const LAS f32x4*)((const LAS float*)aux + ui * 256 + bj * 128 + wc * 32 + 8 * fq + 4 * n);
        int slot[2][4]; float gwv[2][4];
#pragma unroll
        for (int ai = 0; ai < 2; ++ai)
#pragma unroll
            for (int m = 0; m < 4; ++m) { const int rl = rl0 + ai * 128 + m * 16; slot[ai][m] = ((const LAS int*)(aux + 5120))[ui * 256 + rl]; gwv[ai][m] = ((const LAS float*)(aux + 10240))[ui * 256 + rl]; }
#pragma unroll
        for (int ai = 0; ai < 2; ++ai)
#pragma unroll
            for (int m = 0; m < 4; ++m) { const int rl = rl0 + ai * 128 + m * 16;
                if (rl < u.cnt) { const float gw = gwv[ai][m] * YS_SCALE;
                    unsigned char* rowp = yslot + (size_t)slot[ai][m] * DM + col0;
#pragma unroll
                    for (int bj = 0; bj < 2; ++bj) { const f32x4 v0 = (acc[ai][bj][m][0] * (1.0f / (WD_SCALE * ACT_SCALE)) + bv[bj][0]) * gw, v1 = (acc[ai][bj][m][1] * (1.0f / (WD_SCALE * ACT_SCALE)) + bv[bj][1]) * gw;
                        int w0 = __builtin_amdgcn_cvt_pk_fp8_f32(v0[0], v0[1], 0, false); w0 = __builtin_amdgcn_cvt_pk_fp8_f32(v0[2], v0[3], w0, true);
                        int w1 = __builtin_amdgcn_cvt_pk_fp8_f32(v1[0], v1[1], 0, false); w1 = __builtin_amdgcn_cvt_pk_fp8_f32(v1[2], v1[3], w1, true);
                        *(u32x2*)(rowp + bj * 128) = (u32x2){(unsigned)w0, (unsigned)w1}; } } }
    }
};

#define XB_TMO      128
#define XB_XCNT(j)  (256  + 64 * (j))
#define XB_XSUB(j)  (1280 + 64 * (j))
#define XB_XGEN(j)  (2304 + 64 * (j))
#define XB_TOP      3328
#define XB_TOPGEN   3392
#define XCD_BAR_WORDS 3456
#define XB_SPIN_CAP (1u << 18)
__device__ __forceinline__ unsigned xb_ld(unsigned* p)              { return __hip_atomic_load(p, __ATOMIC_RELAXED, __HIP_MEMORY_SCOPE_AGENT); }
__device__ __forceinline__ unsigned xb_add(unsigned* p, unsigned v) { return __hip_atomic_fetch_add(p, v, __ATOMIC_RELAXED, __HIP_MEMORY_SCOPE_AGENT); }
__device__ __forceinline__ unsigned xb_xcc_id() { return (unsigned)__builtin_amdgcn_s_getreg((3 << 11) | 20) & 0xFu; }
#define XB_SPIN(cond, bar) do { unsigned _sp = 0; while (cond) { __builtin_amdgcn_s_sleep(1); \
    if ((++_sp & 255u) == 0u) { if (xb_ld(&(bar)[XB_TMO])) break; if (_sp > XB_SPIN_CAP) { atomicAdd(&(bar)[XB_TMO], 1u); break; } } } } while (0)
struct XcdBarrier { unsigned* bar; unsigned x; volatile LAS unsigned* st; };
__device__ __forceinline__ XcdBarrier xcd_barrier_post(unsigned* bar, volatile LAS unsigned* st) {
    XcdBarrier b; b.bar = bar; b.x = xb_xcc_id(); b.st = st;
    if (threadIdx.x == 0) (void)xb_add(&bar[XB_XCNT(b.x)], 1u);
    return b;
}
__device__ __forceinline__ void xcd_barrier_complete(unsigned* bar, unsigned x, unsigned& nloc, unsigned& nx) {
    const unsigned G = gridDim.x * gridDim.y * gridDim.z;
    unsigned sum, cnt, mine, sp = 0u;
    for (;;) {
        sum = 0u; cnt = 0u; mine = 0u;
#pragma unroll
        for (unsigned j = 0; j < 16; ++j) { const unsigned c = xb_ld(&bar[XB_XCNT(j)]); sum += c; cnt += (c > 0u) ? 1u : 0u; mine = (j == x) ? c : mine; }
        if (sum == G) break;
        __builtin_amdgcn_s_sleep(1);
        if ((++sp & 255u) == 0u) { if (xb_ld(&bar[XB_TMO])) break; if (sp > XB_SPIN_CAP) { atomicAdd(&bar[XB_TMO], 1u); break; } }
    }
    nloc = mine > 0u ? mine : 1u; nx = cnt > 0u ? cnt : 1u;
}
__device__ __forceinline__ void xcd_barrier(const XcdBarrier& b) {
    asm volatile("s_waitcnt vmcnt(0)" ::: "memory");
    __syncthreads();
    if (threadIdx.x == 0) {
        unsigned* bar = b.bar;
        __builtin_amdgcn_s_waitcnt(0);
        __builtin_amdgcn_fence(__ATOMIC_ACQUIRE, "agent");
        unsigned nloc = b.st[0], nx = b.st[1];
        if (nloc == 0u) { xcd_barrier_complete(bar, b.x, nloc, nx); b.st[0] = nloc; b.st[1] = nx; }
        const unsigned old = xb_add(&bar[XB_XSUB(b.x)], 1u);
        const unsigned gen = old / nloc;
        if (old + 1u == (gen + 1u) * nloc) {
            __builtin_amdgcn_fence(__ATOMIC_RELEASE, "agent");
            asm volatile("s_waitcnt vmcnt(0)" ::: "memory");
            const unsigned og = xb_add(&bar[XB_TOP], 1u);
            const unsigned tg = og / nx;
            if (og + 1u == (tg + 1u) * nx) xb_add(&bar[XB_TOPGEN], 1u);
            else XB_SPIN(xb_ld(&bar[XB_TOPGEN]) == tg, bar);
            xb_add(&bar[XB_XGEN(b.x)], 1u);
            asm volatile("s_waitcnt vmcnt(0)" ::: "memory");
        } else {
            XB_SPIN(xb_ld(&bar[XB_XGEN(b.x)]) == gen, bar);
            asm volatile("s_waitcnt vmcnt(0)" ::: "memory");
        }
    }
    __syncthreads();
}

struct Args { const float* in[22]; float* out; unsigned char* ws; int ph_lo, ph_hi; };
enum { I_XIN = 0, I_C, I_ADAW, I_ADAB, I_NMG, I_WIN, I_LBP, I_HNG, I_LNG, I_LNB, I_GWS, I_GBS, I_GNG, I_WOUT, I_NFG, I_RW, I_RB, I_WGU, I_BGU, I_WD, I_BD, I_FG };

template <bool GU>
__device__ __forceinline__ void cvt_item(const float* W, int K, int N, bf16* WT, int item, int lane) {
    const int nblk = N / 64, kb = item / nblk, nb = item - kb * nblk, k0 = 64 * kb, n0 = 64 * nb, q = lane >> 4, c = lane & 15;
    const float* src = W + (size_t)(k0 + 16 * q) * N + n0 + 4 * c;
    f32x4 v[16];
#pragma unroll
    for (int i = 0; i < 16; ++i) v[i] = __builtin_nontemporal_load((const f32x4*)(src + (size_t)i * N));
#pragma unroll
    for (int j = 0; j < 4; ++j) { const int n = n0 + 4 * c + j; int np = n;
        if (GU) { const int hi = n >= 1024, nn = n - hi * 1024; np = ((nn >> 7) << 8) + hi * 128 + (nn & 127); }
        u32x4 lo, hi4;
        lo.x = pk2(v[0][j], v[1][j]); lo.y = pk2(v[2][j], v[3][j]); lo.z = pk2(v[4][j], v[5][j]); lo.w = pk2(v[6][j], v[7][j]);
        hi4.x = pk2(v[8][j], v[9][j]); hi4.y = pk2(v[10][j], v[11][j]); hi4.z = pk2(v[12][j], v[13][j]); hi4.w = pk2(v[14][j], v[15][j]);
        bf16* dst = WT + (size_t)np * K + k0 + 16 * q;
        *(u32x4*)dst = lo; *(u32x4*)(dst + 8) = hi4; }
}
constexpr int XITEMS = NE * (16 * 32 + 16 * 16);
constexpr int XI_P3 = 0, XI_P5 = 1536 * 8, XI_P0 = XI_P5 + 1024 * 8;
struct XItem { const float* W; bf16* WT; int N, r; bool gu; };
__device__ __forceinline__ XItem xitem(const Args& a, int id) {
    XItem x;
    if (id < 16384) { const int e = id >> 9; x.W = a.in[I_WGU] + (size_t)e * DM * 2048; x.WT = (bf16*)(a.ws + WS_WGU) + (size_t)e * 2048 * DM; x.N = 2048; x.r = id & 511; x.gu = true; }
    else if (id < XITEMS) { const int e = (id - 16384) >> 8; x.W = a.in[I_WD] + (size_t)e * DFF * DM; x.WT = (bf16*)(a.ws + WS_WD) + (size_t)e * DM * DFF; x.N = 1024; x.r = (id - 16384) & 255; x.gu = false; }
    else if (id < XITEMS + 768) { x.W = a.in[I_WIN]; x.WT = (bf16*)(a.ws + WS_WIN); x.N = NIN; x.r = id - XITEMS; x.gu = false; }
    else { x.W = a.in[I_WOUT]; x.WT = (bf16*)(a.ws + WS_WOUT); x.N = DM; x.r = id - XITEMS - 768; x.gu = false; }
    return x;
}
__device__ __forceinline__ void xcvt_load(const Args& a, int id, int lane, f32x4 (&v)[16]) {
    const XItem x = xitem(a, id);
    const int nblk = x.N / 64, kb = x.r / nblk, nb = x.r - kb * nblk, q = lane >> 4, c = lane & 15;
    const float* src = x.W + (size_t)(64 * kb + 16 * q) * x.N + 64 * nb + 4 * c;
#pragma unroll
    for (int i = 0; i < 16; ++i) v[i] = __builtin_nontemporal_load((const f32x4*)(src + (size_t)i * x.N));
}
__device__ __forceinline__ void xcvt_store(const Args& a, int id, int lane, const f32x4 (&v)[16]) {
    const XItem x = xitem(a, id);
    const int nblk = x.N / 64, kb = x.r / nblk, nb = x.r - kb * nblk, q = lane >> 4, c = lane & 15;
#pragma unroll
    for (int j = 0; j < 4; ++j) { const int n = 64 * nb + 4 * c + j; int np = n;
        if (x.gu) { const int hi = n >= 1024, nn = n - hi * 1024; np = ((nn >> 7) << 8) + hi * 128 + (nn & 127); }
        if (x.gu) {
            int w[4];
#pragma unroll
            for (int t = 0; t < 4; ++t) { w[t] = __builtin_amdgcn_cvt_pk_fp8_f32(v[4 * t][j] * WGU_SCALE, v[4 * t + 1][j] * WGU_SCALE, 0, false); w[t] = __builtin_amdgcn_cvt_pk_fp8_f32(v[4 * t + 2][j] * WGU_SCALE, v[4 * t + 3][j] * WGU_SCALE, w[t], true); }
            *(u32x4*)((unsigned char*)(a.ws + WS_WGU) + (size_t)(x.WT - (bf16*)(a.ws + WS_WGU)) + (size_t)np * 1024 + 64 * kb + 16 * q) = (u32x4){(unsigned)w[0], (unsigned)w[1], (unsigned)w[2], (unsigned)w[3]};
        } else {
        u32x4 lo, hi4;
        lo.x = pk2(v[0][j], v[1][j]); lo.y = pk2(v[2][j], v[3][j]); lo.z = pk2(v[4][j], v[5][j]); lo.w = pk2(v[6][j], v[7][j]);
        hi4.x = pk2(v[8][j], v[9][j]); hi4.y = pk2(v[10][j], v[11][j]); hi4.z = pk2(v[12][j], v[13][j]); hi4.w = pk2(v[14][j], v[15][j]);
        bf16* dst = x.WT + (size_t)np * 1024 + 64 * kb + 16 * q;
        *(u32x4*)dst = lo; *(u32x4*)(dst + 8) = hi4; } }
}
__device__ __forceinline__ void xcvt_load_h(const Args& a, int id, int half, int lane, f32x4 (&v)[8]) {
    const bool gu = id < 16384; const int r0 = gu ? id : id - 16384, per = gu ? 512 : 256, e = r0 / per, r = r0 - e * per, N = gu ? 2048 : 1024;
    const float* W = gu ? a.in[I_WGU] + (size_t)e * DM * 2048 : a.in[I_WD] + (size_t)e * DFF * DM;
    const int nblk = N / 64, kb = r / nblk, nb = r - kb * nblk, q = lane >> 4, c = lane & 15;
    const float* src = W + (size_t)(64 * kb + 16 * q + 8 * half) * N + 64 * nb + 4 * c;
#pragma unroll
    for (int i = 0; i < 8; ++i) v[i] = __builtin_nontemporal_load((const f32x4*)(src + (size_t)i * N));
}
__device__ __forceinline__ void xcvt_store_h(const Args& a, int id, int half, int lane, const f32x4 (&v)[8]) {
    const bool gu = id < 16384; const int r0 = gu ? id : id - 16384, per = gu ? 512 : 256, e = r0 / per, r = r0 - e * per, N = gu ? 2048 : 1024;
    bf16* WT = gu ? (bf16*)(a.ws + WS_WGU) + (size_t)e * 2048 * DM : (bf16*)(a.ws + WS_WD) + (size_t)e * DM * DFF;
    const int nblk = N / 64, kb = r / nblk, nb = r - kb * nblk, q = lane >> 4, c = lane & 15;
#pragma unroll
    for (int j = 0; j < 4; ++j) { const int n = 64 * nb + 4 * c + j; int np = n;
        if (gu) { const int hi = n >= 1024, nn = n - hi * 1024; np = ((nn >> 7) << 8) + hi * 128 + (nn & 127); }
        if (gu) { u32x4 w; w.x = pk2(v[0][j], v[1][j]); w.y = pk2(v[2][j], v[3][j]); w.z = pk2(v[4][j], v[5][j]); w.w = pk2(v[6][j], v[7][j]);
            *(u32x4*)(WT + (size_t)np * 1024 + 64 * kb + 16 * q + 8 * half) = w; }
        else {
            int w0 = __builtin_amdgcn_cvt_pk_fp8_f32(v[0][j] * WD_SCALE, v[1][j] * WD_SCALE, 0, false); w0 = __builtin_amdgcn_cvt_pk_fp8_f32(v[2][j] * WD_SCALE, v[3][j] * WD_SCALE, w0, true);
            int w1 = __builtin_amdgcn_cvt_pk_fp8_f32(v[4][j] * WD_SCALE, v[5][j] * WD_SCALE, 0, false); w1 = __builtin_amdgcn_cvt_pk_fp8_f32(v[6][j] * WD_SCALE, v[7][j] * WD_SCALE, w1, true);
            *(u32x2*)((unsigned char*)(a.ws + WS_WD) + ((size_t)e * DM + np) * DFF + 64 * kb + 16 * q + 8 * half) = (u32x2){(unsigned)w0, (unsigned)w1}; } }
}
__device__ __forceinline__ void p0_prologue(const Args& a, LAS unsigned char* lds, int vcu, int G, int tid, int wave, int lane) {
    unsigned char* ws = a.ws;
    if (vcu < 96) {
        LAS float* cact = (LAS float*)lds;
        LAS float* ps = (LAS float*)(lds + 16384);
        { float cvv[8];
#pragma unroll
          for (int it = 0; it < 8; ++it) cvv[it] = a.in[I_C][tid + 512 * it];
#pragma unroll
          for (int it = 0; it < 8; ++it) cact[tid + 512 * it] = cvv[it] * fsigmoid(cvv[it]); }
        __syncthreads();
        const float* w = a.in[I_ADAW] + (size_t)(128 * wave) * 6144 + 64 * vcu + lane;
        float s0 = 0.f, s1 = 0.f, s2 = 0.f, s3 = 0.f;
#pragma unroll 64
        for (int k = 0; k < 128; ++k) { const float wv = w[(size_t)k * 6144]; const int kk = 128 * wave + k;
            s0 += cact[kk] * wv; s1 += cact[1024 + kk] * wv; s2 += cact[2048 + kk] * wv; s3 += cact[3072 + kk] * wv; }
        ps[(wave * 4 + 0) * 64 + lane] = s0; ps[(wave * 4 + 1) * 64 + lane] = s1; ps[(wave * 4 + 2) * 64 + lane] = s2; ps[(wave * 4 + 3) * 64 + lane] = s3;
        __syncthreads();
        if (wave < 4) { float s = a.in[I_ADAB][64 * vcu + lane];
#pragma unroll
            for (int w8 = 0; w8 < 8; ++w8) s += ps[(w8 * 4 + wave) * 64 + lane];
            __hip_atomic_store((float*)(ws + WS_MOD) + wave * 6144 + 64 * vcu + lane, s, __ATOMIC_RELAXED, __HIP_MEMORY_SCOPE_AGENT); }
        asm volatile("s_waitcnt vmcnt(0)" ::: "memory");
        __syncthreads();
        if (tid == 0) __hip_atomic_fetch_add((unsigned*)(ws + WS_CTL) + CW_MODRDY, 1u, __ATOMIC_RELAXED, __HIP_MEMORY_SCOPE_AGENT);
    }
    if (vcu == G - 1) { const float p0 = a.in[I_LBP][tid], p1 = a.in[I_LBP][512 + tid]; ((float*)(ws + WS_LB))[tid] = fsigmoid(p0 - p1); }
    if (vcu >= 96 && vcu < 160) { bf16* wrh = (bf16*)(ws + WS_WRH); bf16* wrl = (bf16*)(ws + WS_WRL);
        { const int idx = (vcu - 96) * 512 + tid; const int k = idx >> 5, e = idx & 31; const float w = a.in[I_RW][idx];
            const unsigned hi = pk2(w, 0.f) & 0xffffu; const float r = w - __uint_as_float(hi << 16);
            const unsigned lo16 = pk2(r, 0.f) & 0xffffu, hi2 = (unsigned)__shfl_down((int)hi, 32), lo2 = (unsigned)__shfl_down((int)lo16, 32);
            if (lane < 32) { *(unsigned*)(wrh + e * 1024 + k) = hi | (hi2 << 16); *(unsigned*)(wrl + e * 1024 + k) = lo16 | (lo2 << 16); } }
        { const int i2 = (vcu - 96) * 1024 + 2 * tid, t = (i2 >> 7) & 127, sc = i2 & 127; const f32x2 w = *(const f32x2*)(a.in[I_GWS] + i2);
            *(unsigned*)(ws + WS_GWS + (size_t)i2 * 2) = pk2(sc <= t ? w.x : 0.f, sc + 1 <= t ? w.y : 0.f); } }
    const int gw = (vcu - 96) * 8 + wave, NGW = (G - 96) * 8;
    constexpr int I_IN = 0, I_OUT = 16 * 16, I_X = 0;
    constexpr int NITEMS = I_IN + I_OUT + I_X;
    const int it0 = vcu < 96 ? 0 : (int)((long)gw * NITEMS / NGW), it1 = vcu < 96 ? 0 : (int)((long)(gw + 1) * NITEMS / NGW);
#define P0_ID(it_) (XITEMS + 768 + (it_))
    f32x4 ca[16], cb[16];
    if (it0 < it1) xcvt_load(a, P0_ID(it0), lane, ca);
    for (int it = it0; it < it1; it += 2) {
        if (it + 1 < it1) xcvt_load(a, P0_ID(it + 1), lane, cb);
        xcvt_store(a, P0_ID(it), lane, ca);
        if (it + 2 < it1) xcvt_load(a, P0_ID(it + 2), lane, ca);
        if (it + 1 < it1) xcvt_store(a, P0_ID(it + 1), lane, cb);
    }
#undef P0_ID
    if (vcu >= 160 && vcu < 208) {
        const int nb = vcu - 160, q = lane >> 4, c = lane & 15;
        xcvt_load(a, XITEMS + wave * 48 + nb, lane, ca); xcvt_load(a, XITEMS + (wave + 8) * 48 + nb, lane, cb);
        float mx[4] = {0.f, 0.f, 0.f, 0.f};
#pragma unroll
        for (int i = 0; i < 16; ++i)
#pragma unroll
            for (int j = 0; j < 4; ++j) mx[j] = fmaxf(mx[j], fmaxf(fabsf(ca[i][j]), fabsf(cb[i][j])));
#pragma unroll
        for (int j = 0; j < 4; ++j) { mx[j] = fmaxf(mx[j], __shfl_xor(mx[j], 16)); mx[j] = fmaxf(mx[j], __shfl_xor(mx[j], 32)); }
        LAS float* cm = (LAS float*)(lds + 24576);
        if (q == 0) *(LAS f32x4*)(cm + wave * 64 + 4 * c) = (f32x4){mx[0], mx[1], mx[2], mx[3]};
        lds_barrier();
        f32x4 cmx = *(const LAS f32x4*)(cm + 4 * c);
#pragma unroll
        for (int w8 = 1; w8 < 8; ++w8) { const f32x4 t = *(const LAS f32x4*)(cm + w8 * 64 + 4 * c); cmx.x = fmaxf(cmx.x, t.x); cmx.y = fmaxf(cmx.y, t.y); cmx.z = fmaxf(cmx.z, t.z); cmx.w = fmaxf(cmx.w, t.w); }
        if (wave == 0 && q == 0) *(f32x4*)((float*)(ws + WS_SB) + 64 * nb + 4 * c) = cmx * (1.0f / 127.0f);
        unsigned char* W8 = ws + WS_WIN;
#pragma unroll
        for (int it = 0; it < 2; ++it) { const int kb = wave + 8 * it;
#pragma unroll
            for (int j = 0; j < 4; ++j) { const float cmj = cmx[j], qs = cmj > 0.f ? 127.0f / cmj : 0.f; unsigned w4[4];
#pragma unroll
                for (int t = 0; t < 4; ++t) { int qv[4];
#pragma unroll
                    for (int u = 0; u < 4; ++u) qv[u] = __float2int_rn((it ? cb[4 * t + u][j] : ca[4 * t + u][j]) * qs);
                    w4[t] = (unsigned)(qv[0] & 255) | ((unsigned)(qv[1] & 255) << 8) | ((unsigned)(qv[2] & 255) << 16) | ((unsigned)qv[3] << 24); }
                *(u32x4*)(W8 + (size_t)(64 * nb + 4 * c + j) * 1024 + 64 * kb + 16 * q) = (u32x4){w4[0], w4[1], w4[2], w4[3]}; } }
    }
}

__device__ __forceinline__ void mod_wait(const Args& a, int tid) {
    if (tid == 0) { unsigned* ctl = (unsigned*)(a.ws + WS_CTL); unsigned sp = 0;
        while (__hip_atomic_load(ctl + CW_MODRDY, __ATOMIC_RELAXED, __HIP_MEMORY_SCOPE_AGENT) < 96u) { __builtin_amdgcn_s_sleep(2);
            if ((++sp & 255u) == 0u) { if (__hip_atomic_load(ctl + CW_TMO, __ATOMIC_RELAXED, __HIP_MEMORY_SCOPE_AGENT)) break; if (sp > (1u << 20)) { __hip_atomic_store(ctl + CW_TMO, 1u, __ATOMIC_RELAXED, __HIP_MEMORY_SCOPE_AGENT); break; } } }
        __builtin_amdgcn_fence(__ATOMIC_ACQUIRE, "agent"); asm volatile("s_waitcnt vmcnt(0)" ::: "memory"); }
    __syncthreads();
}
__device__ __forceinline__ void h1_load4(const Args& a, int m0, int NGW, int lane, f32x4 (&v)[4][4], float (&rstd)[4]) {
#pragma unroll
    for (int r = 0; r < 4; ++r) { const int m = m0 + r * NGW; const f32x4* xr = (const f32x4*)(a.in[I_XIN] + (size_t)(m < MT ? m : 0) * DM) + lane;
#pragma unroll
        for (int j = 0; j < 4; ++j) v[r][j] = xr[64 * j]; }
#pragma unroll
    for (int r = 0; r < 4; ++r) { float ss = 0.f;
#pragma unroll
        for (int j = 0; j < 4; ++j) ss += (v[r][j].x * v[r][j].x + v[r][j].y * v[r][j].y) + (v[r][j].z * v[r][j].z + v[r][j].w * v[r][j].w);
        rstd[r] = rsqrtf(wave_sum(ss) * (1.0f / DM) + EPS); }
}
constexpr int H1_MOD = 32768;
__device__ __forceinline__ void h1_store4(const Args& a, const LAS unsigned char* lds, int m0, int NGW, int lane, const f32x4 (&v)[4][4], const float (&rstd)[4]) {
    const LAS float* mod = (const LAS float*)(lds + H1_MOD); bf16* H = (bf16*)(a.ws + WS_H);
    f32x4 gq[4];
#pragma unroll
    for (int j = 0; j < 4; ++j) gq[j] = *(const f32x4*)(a.in[I_NMG] + 4 * lane + 256 * j);
#pragma unroll
    for (int rp = 0; rp < 2; ++rp) { f32x4 shq[2][4], scq[2][4];
#pragma unroll
        for (int rr = 0; rr < 2; ++rr) { const int m = m0 + (2 * rp + rr) * NGW, b = (m < MT ? m : 0) / SEQ;
#pragma unroll
            for (int j = 0; j < 4; ++j) { const int c = 4 * lane + 256 * j; shq[rr][j] = *(const LAS f32x4*)(mod + b * 2048 + c); scq[rr][j] = *(const LAS f32x4*)(mod + b * 2048 + 1024 + c); } }
#pragma unroll
        for (int rr = 0; rr < 2; ++rr) { const int r = 2 * rp + rr, m = m0 + r * NGW;
            { f32x4 h[4]; float mx = 0.f;
#pragma unroll
              for (int j = 0; j < 4; ++j) { h[j] = (v[r][j] * rstd[r]) * gq[j] * (scq[rr][j] + 1.0f) + shq[rr][j]; mx = fmaxf(mx, fmaxf(fmaxf(fabsf(h[j].x), fabsf(h[j].y)), fmaxf(fabsf(h[j].z), fabsf(h[j].w)))); }
#pragma unroll
              for (int o = 1; o < 64; o <<= 1) mx = fmaxf(mx, __shfl_xor(mx, o));
              const float qs = mx > 0.f ? 127.0f / mx : 0.f;
              if (m < MT) { unsigned* o4 = (unsigned*)((unsigned char*)H + (size_t)m * DM) + lane;
                  if (lane == 0) ((float*)(a.ws + WS_SA))[m] = mx * (1.0f / 127.0f);
#pragma unroll
                  for (int j = 0; j < 4; ++j) { const int q0 = __float2int_rn(h[j].x * qs), q1 = __float2int_rn(h[j].y * qs), q2 = __float2int_rn(h[j].z * qs), q3 = __float2int_rn(h[j].w * qs);
                      o4[64 * j] = (unsigned)(q0 & 255) | ((unsigned)(q1 & 255) << 8) | ((unsigned)(q2 & 255) << 16) | ((unsigned)q3 << 24); } } } } }
}
__device__ __forceinline__ void p1_h1(const Args& a, LAS unsigned char* lds, int vcu, int G, int tid, int wave, int lane) {
    const int gw = vcu * 8 + wave, NGW = G * 8;
    f32x4 v[4][4], v2[4][4]; float rstd[4], rstd2[4];
    h1_load4(a, gw, NGW, lane, v, rstd);
    h1_load4(a, gw + 4 * NGW, NGW, lane, v2, rstd2);
    mod_wait(a, tid);
    { const float* mod = (const float*)(a.ws + WS_MOD); f32x4 t4[4];
#pragma unroll
      for (int it = 0; it < 4; ++it) { const int idx = tid + 512 * it; t4[it] = *(const f32x4*)(mod + (idx >> 9) * 6144 + 4 * (idx & 511)); }
#pragma unroll
      for (int it = 0; it < 4; ++it) { const int idx = tid + 512 * it; *(LAS f32x4*)(lds + H1_MOD + ((idx >> 9) * 2048 + 4 * (idx & 511)) * 4) = t4[it]; } }
    lds_barrier();
    h1_store4(a, lds, gw, NGW, lane, v, rstd);
    h1_store4(a, lds, gw + 4 * NGW, NGW, lane, v2, rstd2);
    for (int m0 = gw + 8 * NGW; m0 < MT; m0 += 4 * NGW) { h1_load4(a, m0, NGW, lane, v, rstd); h1_store4(a, lds, m0, NGW, lane, v, rstd); }
}

constexpr int RT_WH = 0, RT_WL = 66048, RT_LG = 132096, RT_SSQ = RT_LG + 16384, RT_SEL = RT_SSQ + 512, RT_GS = RT_SEL + 3584, RT_SH = RT_GS + 4096, RT_RB = RT_SH + 4096;
static_assert(RT_RB + 128 <= LDSCTL_OFF, "router lds");
__device__ __forceinline__ void p6_router(const Args& a, LAS unsigned char* lds, int vcu, int G, int tid, int wave, int lane, bool dry) {
    LAS float* LG = (LAS float*)(lds + RT_LG); LAS float* SSQ = (LAS float*)(lds + RT_SSQ);
    LAS int* sel_e = (LAS int*)(lds + RT_SEL); LAS int* sel_p = sel_e + 256; LAS int* hist = sel_p + 256; LAS int* base = hist + 32; LAS float* sel_g = (LAS float*)(base + 32);
    LAS float* GS = (LAS float*)(lds + RT_GS); LAS float* SH = (LAS float*)(lds + RT_SH); LAS float* RBL = (LAS float*)(lds + RT_RB);
    { const u32x4* wh = (const u32x4*)(a.ws + WS_WRH); const u32x4* wlo = (const u32x4*)(a.ws + WS_WRL);
      u32x4 th[8], tl[8];
#pragma unroll
      for (int it = 0; it < 8; ++it) { th[it] = wh[tid + 512 * it]; tl[it] = wlo[tid + 512 * it]; }
#pragma unroll
      for (int it = 0; it < 8; ++it) { const int idx = tid + 512 * it, e = idx >> 7, c = idx & 127; *(LAS u32x4*)(lds + RT_WH + e * 2064 + c * 16) = th[it]; *(LAS u32x4*)(lds + RT_WL + e * 2064 + c * 16) = tl[it]; } }
    if (tid < 32) { hist[tid] = 0; RBL[tid] = a.in[I_RB][tid]; }
    lds_barrier();
    const float* mod = (const float*)(a.ws + WS_MOD);
    const bf16* xmid = (const bf16*)(a.ws + WS_XMID);
    bf16* H = (bf16*)(a.ws + WS_H);
    float* lgate = (float*)(a.ws + WS_LGATE);
    int* lists = (int*)(a.ws + WS_LISTS);
    unsigned* cntg = (unsigned*)(a.ws + WS_CTL) + CW_CNT;
    const int rb = wave & 3, kh = wave >> 2, fr = lane & 15, q = lane >> 4;
    for (int blk = vcu; blk < MT / 64; blk += G) {
        const int row0 = blk * 64, b = row0 / SEQ, row = row0 + 16 * rb + fr;
        for (int k = tid; k < DM; k += 512) { GS[k] = a.in[I_NFG][k] * (mod[b * 6144 + 4096 + k] + 1.0f); SH[k] = mod[b * 6144 + 3072 + k]; }
        const bf16* xr = xmid + (size_t)row * DM + 512 * kh + 8 * q;
        f32x4 x[16][2]; float ss = 0.f;
        { u32x4 xb[16];
#pragma unroll
          for (int ks = 0; ks < 16; ++ks) xb[ks] = *(const u32x4*)(xr + 32 * ks);
#pragma unroll
          for (int ks = 0; ks < 16; ++ks) { x[ks][0] = (f32x4){bflo(xb[ks].x), bfhi(xb[ks].x), bflo(xb[ks].y), bfhi(xb[ks].y)}; x[ks][1] = (f32x4){bflo(xb[ks].z), bfhi(xb[ks].z), bflo(xb[ks].w), bfhi(xb[ks].w)}; } }
#pragma unroll
        for (int ks = 0; ks < 16; ++ks)
#pragma unroll
            for (int hh = 0; hh < 2; ++hh) ss += (x[ks][hh].x * x[ks][hh].x + x[ks][hh].y * x[ks][hh].y) + (x[ks][hh].z * x[ks][hh].z + x[ks][hh].w * x[ks][hh].w);
        ss += __shfl_xor(ss, 16); ss += __shfl_xor(ss, 32);
        if (q == 0) SSQ[kh * 64 + 16 * rb + fr] = ss;
        lds_barrier();
        const float rstd = rsqrtf((SSQ[16 * rb + fr] + SSQ[64 + 16 * rb + fr]) * (1.0f / DM) + EPS);
        f32x4 acc[2] = {(f32x4){0.f, 0.f, 0.f, 0.f}, (f32x4){0.f, 0.f, 0.f, 0.f}};
#pragma unroll
        for (int ks = 0; ks < 16; ++ks) { const int k = 512 * kh + 32 * ks + 8 * q;
            unsigned hp[4], lp[4];
#pragma unroll
            for (int hh = 0; hh < 2; ++hh) { const f32x4 gs = *(const LAS f32x4*)(GS + k + 4 * hh), sh = *(const LAS f32x4*)(SH + k + 4 * hh);
                const f32x4 h = (x[ks][hh] * rstd) * gs + sh;
                hp[2 * hh] = pk2(h.x, h.y); hp[2 * hh + 1] = pk2(h.z, h.w);
                lp[2 * hh] = pk2(h.x - bflo(hp[2 * hh]), h.y - bfhi(hp[2 * hh])); lp[2 * hh + 1] = pk2(h.z - bflo(hp[2 * hh + 1]), h.w - bfhi(hp[2 * hh + 1])); }
            { int w0 = 0, w1 = 0;
              { const f32x4 ha = (x[ks][0] * rstd) * *(const LAS f32x4*)(GS + k) + *(const LAS f32x4*)(SH + k), hb = (x[ks][1] * rstd) * *(const LAS f32x4*)(GS + k + 4) + *(const LAS f32x4*)(SH + k + 4);
                w0 = __builtin_amdgcn_cvt_pk_fp8_f32(ha.x * H2_SCALE, ha.y * H2_SCALE, 0, false); w0 = __builtin_amdgcn_cvt_pk_fp8_f32(ha.z * H2_SCALE, ha.w * H2_SCALE, w0, true);
                w1 = __builtin_amdgcn_cvt_pk_fp8_f32(hb.x * H2_SCALE, hb.y * H2_SCALE, 0, false); w1 = __builtin_amdgcn_cvt_pk_fp8_f32(hb.z * H2_SCALE, hb.w * H2_SCALE, w1, true); }
              *(u32x2*)((unsigned char*)H + (size_t)row * DM + k) = (u32x2){(unsigned)w0, (unsigned)w1}; }
            const bf16x8 ah = mk_frag(hp[0], hp[1], hp[2], hp[3]), al = mk_frag(lp[0], lp[1], lp[2], lp[3]);
#pragma unroll
            for (int nb = 0; nb < 2; ++nb) { const bf16x8 bh = *(const LAS bf16x8*)(lds + RT_WH + (16 * nb + fr) * 2064 + k * 2), bl = *(const LAS bf16x8*)(lds + RT_WL + (16 * nb + fr) * 2064 + k * 2);
                acc[nb] = __builtin_amdgcn_mfma_f32_16x16x32_bf16(ah, bh, acc[nb], 0, 0, 0); acc[nb] = __builtin_amdgcn_mfma_f32_16x16x32_bf16(al, bh, acc[nb], 0, 0, 0); acc[nb] = __builtin_amdgcn_mfma_f32_16x16x32_bf16(ah, bl, acc[nb], 0, 0, 0); }
            asm volatile("" ::: "memory"); }
#pragma unroll
        for (int nb = 0; nb < 2; ++nb)
#pragma unroll
            for (int r = 0; r < 4; ++r) LG[(kh * 64 + 16 * rb + 4 * q + r) * 32 + 16 * nb + fr] = acc[nb][r];
        lds_barrier();
#pragma unroll 1
        for (int it = 0; it < 4; ++it) { const int r = 8 * wave + 2 * it + (lane >> 5), e = lane & 31;
            float lv[32];
#pragma unroll
            for (int c = 0; c < 8; ++c) { const f32x4 a0 = *(const LAS f32x4*)(LG + r * 32 + 4 * c), a1 = *(const LAS f32x4*)(LG + (64 + r) * 32 + 4 * c), rbv = *(const LAS f32x4*)(RBL + 4 * c);
                const f32x4 t = (a0 + a1) + rbv; lv[4 * c] = t.x; lv[4 * c + 1] = t.y; lv[4 * c + 2] = t.z; lv[4 * c + 3] = t.w; }
            const float val = (LG[r * 32 + e] + LG[(64 + r) * 32 + e]) + RBL[e];
            int rank = 0;
#pragma unroll
            for (int e2 = 0; e2 < 32; ++e2) rank += (lv[e2] > val || (lv[e2] == val && e2 < e)) ? 1 : 0;
            float mx = val;
#pragma unroll
            for (int o = 1; o < 32; o <<= 1) mx = fmaxf(mx, __shfl_xor(mx, o));
            const float ex = rank < 4 ? __expf(val - mx) : 0.f; float sm = ex;
#pragma unroll
            for (int o = 1; o < 32; o <<= 1) sm += __shfl_xor(sm, o);
            if (rank < 4) { const int li = r * 4 + rank; sel_g[li] = ex * __builtin_amdgcn_rcpf(sm); sel_e[li] = e; if (!dry) sel_p[li] = __hip_atomic_fetch_add(&hist[e], 1, __ATOMIC_RELAXED, __HIP_MEMORY_SCOPE_WORKGROUP); }
        }
        lds_barrier();
        if (!dry) {
            int t2 = tid; asm volatile("" : "+v"(t2));
            if (t2 < 32) base[t2] = (int)__hip_atomic_fetch_add(cntg + CNT_STRIDE * t2, (unsigned)hist[t2], __ATOMIC_RELAXED, __HIP_MEMORY_SCOPE_AGENT);
            lds_barrier();
            if (tid < 256) { const int e = sel_e[tid]; const size_t li = (size_t)e * LSTRIDE + base[e] + sel_p[tid]; lists[li] = (row0 + (tid >> 2)) * 4 + (tid & 3); lgate[li] = sel_g[tid]; }
            lds_barrier();
            if (tid < 32) hist[tid] = 0;
        }
        lds_barrier();
    }
}

typedef __attribute__((__vector_size__(8 * sizeof(short)))) short bf16x8v;
constexpr int HG_T = 0;
constexpr int HG_QT = 4096;
constexpr int HG_QH = HG_QT + 17408;
constexpr int HG_KH = HG_QH + 17408;
constexpr int HG_VT = HG_KH + 43520;
constexpr int HG_KD = HG_VT + 18432;
constexpr int HG_SS = HG_KD + 18432;
static_assert(HG_SS + 512 <= LDSCTL_OFF, "hgrn lds");

#define HG_LOAD_A(unit_, L_, V_) do { const int _bh = (unit_) >> 6, _c = (unit_) & 63; const bf16* _zp = Z + ((size_t)(_bh >> 2) * SEQ + _c * 64 + 8 * wave) * NIN + (_bh & 3) * 128 + 2 * lane; \
    _Pragma("unroll") for (int _i = 0; _i < 8; ++_i) { L_[_i] = *(const unsigned*)(_zp + (size_t)_i * NIN + 512); V_[_i] = *(const unsigned*)(_zp + (size_t)_i * NIN + 1024); } } while (0)
__device__ __forceinline__ void hgrnA_phase(const Args& a, LAS unsigned char* lds, int bx, int G, int wave, int lane) {
    const bf16* Z = (const bf16*)(a.ws + WS_Z); bf16* KVT = (bf16*)(a.ws + WS_KV); float* DEC = (float*)(a.ws + WS_DEC);
    const int fr = lane & 15, q = lane >> 4;
    unsigned pl[8], pv[8];
    if (bx < 1024) HG_LOAD_A(bx, pl, pv);
    for (int unit = bx; unit < 1024; unit += G) {
        unsigned cl[8], vw[8];
#pragma unroll
        for (int i = 0; i < 8; ++i) { cl[i] = pl[i]; vw[i] = pv[i]; }
        if (unit + G < 1024) HG_LOAD_A(unit + G, pl, pv);
        float f0[8], f1[8], s0 = 0.f, s1 = 0.f;
#pragma unroll
        for (int i = 0; i < 8; ++i) { const float l0 = bflo(cl[i]), l1 = bfhi(cl[i]); s0 += l0; s1 += l1; f0[i] = __builtin_amdgcn_exp2f(l0); f1[i] = __builtin_amdgcn_exp2f(l1); }
        LAS float* T = (LAS float*)(lds + HG_T);
        *(LAS f32x2*)(T + wave * 128 + 2 * lane) = (f32x2){s0, s1};
        lds_barrier();
        float suf0 = 0.f, suf1 = 0.f, tot0 = 0.f, tot1 = 0.f;
#pragma unroll
        for (int w = 0; w < 8; ++w) { const f32x2 t = *(const LAS f32x2*)(T + w * 128 + 2 * lane); if (w > wave) { suf0 += t.x; suf1 += t.y; } tot0 += t.x; tot1 += t.y; }
        float S0 = __builtin_amdgcn_exp2f(suf0), S1 = __builtin_amdgcn_exp2f(suf1);
        float kd0[8], kd1[8];
#pragma unroll
        for (int i = 7; i >= 0; --i) { kd0[i] = (1.0f - f0[i]) * S0; kd1[i] = (1.0f - f1[i]) * S1; S0 *= f0[i]; S1 *= f1[i]; }
        { u32x4 w0 = {pk2(kd0[0], kd0[1]), pk2(kd0[2], kd0[3]), pk2(kd0[4], kd0[5]), pk2(kd0[6], kd0[7])}, w1 = {pk2(kd1[0], kd1[1]), pk2(kd1[2], kd1[3]), pk2(kd1[4], kd1[5]), pk2(kd1[6], kd1[7])};
          *(LAS u32x4*)(lds + HG_KD + (2 * lane) * 144 + 16 * wave) = w0; *(LAS u32x4*)(lds + HG_KD + (2 * lane + 1) * 144 + 16 * wave) = w1; }
        { u32x4 w0, w1;
          w0.x = (vw[0] & 0xffffu) | (vw[1] << 16); w0.y = (vw[2] & 0xffffu) | (vw[3] << 16); w0.z = (vw[4] & 0xffffu) | (vw[5] << 16); w0.w = (vw[6] & 0xffffu) | (vw[7] << 16);
          w1.x = (vw[0] >> 16) | (vw[1] & 0xffff0000u); w1.y = (vw[2] >> 16) | (vw[3] & 0xffff0000u); w1.z = (vw[4] >> 16) | (vw[5] & 0xffff0000u); w1.w = (vw[6] >> 16) | (vw[7] & 0xffff0000u);
          *(LAS u32x4*)(lds + HG_VT + (2 * lane) * 144 + 16 * wave) = w0; *(LAS u32x4*)(lds + HG_VT + (2 * lane + 1) * 144 + 16 * wave) = w1; }
        if (wave == 0) *(f32x2*)(DEC + (size_t)unit * 128 + 2 * lane) = (f32x2){__builtin_amdgcn_exp2f(tot0), __builtin_amdgcn_exp2f(tot1)};
        lds_barrier();
        f32x4 acc[8];
#pragma unroll
        for (int n = 0; n < 8; ++n) acc[n] = (f32x4){0.f, 0.f, 0.f, 0.f};
#pragma unroll
        for (int ks = 0; ks < 2; ++ks) { const bf16x8 af = *(const LAS bf16x8*)(lds + HG_KD + (16 * wave + fr) * 144 + ks * 64 + q * 16);
#pragma unroll
            for (int n = 0; n < 8; ++n) { const bf16x8 bfr = *(const LAS bf16x8*)(lds + HG_VT + (16 * n + fr) * 144 + ks * 64 + q * 16); acc[n] = __builtin_amdgcn_mfma_f32_16x16x32_bf16(af, bfr, acc[n], 0, 0, 0); } }
        bf16* kv = KVT + (size_t)unit * 16384 + 16 * wave + 4 * q;
#pragma unroll
        for (int n = 0; n < 8; ++n) { u32x2 w = {pk2(acc[n][0], acc[n][1]), pk2(acc[n][2], acc[n][3])}; *(u32x2*)(kv + (size_t)(16 * n + fr) * 128) = w; }
        lds_barrier();
    }
}
__device__ __forceinline__ void hgrnB_scan(bf16* KVT, bf16* OUTT, const float* DEC, int gtid, int nthreads) {
    for (int idx = gtid; idx < 16 * 128 * 64; idx += nthreads) {
        const int bh = idx >> 13, rem = idx & 8191, vv = rem >> 6, kp = rem & 63;
        unsigned* p = (unsigned*)(KVT + (size_t)bh * 64 * 16384 + (size_t)vv * 128 + 2 * kp);
        unsigned* po = (unsigned*)(OUTT + (size_t)bh * 64 * 16384 + (size_t)vv * 128 + 2 * kp);
        const float* d = DEC + (size_t)bh * 64 * 128 + 2 * kp;
        float s0 = 0.f, s1 = 0.f;
#pragma unroll 1
        for (int c0 = 0; c0 < 64; c0 += 32) {
            unsigned w[32]; f32x2 dd[32];
#pragma unroll
            for (int i = 0; i < 32; ++i) { w[i] = p[(size_t)(c0 + i) * 8192]; dd[i] = *(const f32x2*)(d + (c0 + i) * 128); }
#pragma unroll
            for (int i = 0; i < 32; ++i) { po[(size_t)(c0 + i) * 8192] = pk2(s0, s1); s0 = dd[i].x * s0 + bflo(w[i]); s1 = dd[i].y * s1 + bfhi(w[i]); }
        }
    }
}
#define HG_LOAD_C(unit_, Q_, L_, V_) do { const int _bh = (unit_) >> 6, _c = (unit_) & 63; const bf16* _zp = Z + ((size_t)(_bh >> 2) * SEQ + _c * 64 + 8 * wave) * NIN + (_bh & 3) * 128 + 2 * lane; \
    _Pragma("unroll") for (int _i = 0; _i < 8; ++_i) { Q_[_i] = *(const unsigned*)(_zp + (size_t)_i * NIN); L_[_i] = *(const unsigned*)(_zp + (size_t)_i * NIN + 512); V_[_i] = *(const unsigned*)(_zp + (size_t)_i * NIN + 1024); } } while (0)
__device__ __forceinline__ void hgrnC_phase(const Args& a, LAS unsigned char* lds, int bx, int G, int wave, int lane) {
    const bf16* Z = (const bf16*)(a.ws + WS_Z); const bf16* SPT = (const bf16*)(a.ws + WS_KV); const float* ng = a.in[I_HNG]; bf16* YMIX = (bf16*)(a.ws + WS_YMIX);
    const int fr = lane & 15, q = lane >> 4, ti = wave >> 1, nh = wave & 1, own = wave >> 1;
    unsigned pq[8], pl[8], pv[8];
    if (bx < 1024) HG_LOAD_C(bx, pq, pl, pv);
    for (int unit = bx; unit < 1024; unit += G) {
        const int bh = unit >> 6, c = unit & 63, b = bh >> 2, h = bh & 3;
        const size_t rowc = (size_t)b * SEQ + c * 64;
        unsigned cq[8], cl[8], vw[8];
#pragma unroll
        for (int i = 0; i < 8; ++i) { cq[i] = pq[i]; cl[i] = pl[i]; vw[i] = pv[i]; }
        bf16x8 sf[4][4];
        { const bf16* sp = SPT + (size_t)unit * 16384 + (size_t)(64 * nh + fr) * 128 + 8 * q;
#pragma unroll
          for (int n = 0; n < 4; ++n)
#pragma unroll
              for (int ks = 0; ks < 4; ++ks) sf[n][ks] = *(const bf16x8*)(sp + n * 16 * 128 + ks * 32); }
        if (unit + G < 1024) HG_LOAD_C(unit + G, pq, pl, pv);
        const int xid = 16384 + unit * 8 + wave;
        f32x4 cv[8]; xcvt_load_h(a, xid, 0, lane, cv);
        float f0[8], f1[8], s0 = 0.f, s1 = 0.f;
#pragma unroll
        for (int i = 0; i < 8; ++i) { const float l0 = bflo(cl[i]), l1 = bfhi(cl[i]); s0 += l0; s1 += l1; f0[i] = __builtin_amdgcn_exp2f(l0); f1[i] = __builtin_amdgcn_exp2f(l1); }
        LAS float* T = (LAS float*)(lds + HG_T);
        *(LAS f32x2*)(T + wave * 128 + 2 * lane) = (f32x2){s0, s1};
        lds_barrier();
        float off0 = 0.f, off1 = 0.f, ro0 = 0.f, ro1 = 0.f; float cr0[4], cr1[4];
        { float a0 = 0.f, a1 = 0.f;
#pragma unroll
          for (int w = 0; w < 8; ++w) { if ((w & 1) == 0) { cr0[w >> 1] = a0; cr1[w >> 1] = a1; }
              const f32x2 t = *(const LAS f32x2*)(T + w * 128 + 2 * lane);
              if (w < wave) { off0 += t.x; off1 += t.y; } if (w < (wave & ~1)) { ro0 += t.x; ro1 += t.y; } a0 += t.x; a1 += t.y; } }
        const float eoff0 = __builtin_amdgcn_exp2f(off0), eoff1 = __builtin_amdgcn_exp2f(off1), eoo0 = __builtin_amdgcn_exp2f(off0 - ro0), eoo1 = __builtin_amdgcn_exp2f(off1 - ro1);
        float ck0[4], ck1[4];
#pragma unroll
        for (int ip = 0; ip < 4; ++ip) { ck0[ip] = __builtin_amdgcn_exp2f(fminf(cr0[ip] - (off0 + s0), 100.f)); ck1[ip] = __builtin_amdgcn_exp2f(fminf(cr1[ip] - (off1 + s1), 100.f)); }
        { float E0 = 1.f, E1 = 1.f;
#pragma unroll
          for (int i = 0; i < 8; ++i) { const int t = 8 * wave + i; E0 *= f0[i]; E1 *= f1[i]; const float q0 = bflo(cq[i]), q1 = bfhi(cq[i]);
              *(LAS unsigned*)(lds + HG_QT + t * 272 + 4 * lane) = pk2(q0 * (E0 * eoff0), q1 * (E1 * eoff1));
              *(LAS unsigned*)(lds + HG_QH + t * 272 + 4 * lane) = pk2(q0 * (E0 * eoo0), q1 * (E1 * eoo1)); } }
        { float S0 = 1.f, S1 = 1.f;
#pragma unroll
          for (int i = 7; i >= 0; --i) { const int t = 8 * wave + i; const float k0 = (1.0f - f0[i]) * S0, k1 = (1.0f - f1[i]) * S1; S0 *= f0[i]; S1 *= f1[i];
#pragma unroll
              for (int ip = 0; ip < 4; ++ip) { if (ip >= own) *(LAS unsigned*)(lds + HG_KH + (8 * ip * (ip + 1) + t) * 272 + 4 * lane) = pk2(k0 * ck0[ip], k1 * ck1[ip]); } } }
        { u32x4 w0, w1;
          w0.x = (vw[0] & 0xffffu) | (vw[1] << 16); w0.y = (vw[2] & 0xffffu) | (vw[3] << 16); w0.z = (vw[4] & 0xffffu) | (vw[5] << 16); w0.w = (vw[6] & 0xffffu) | (vw[7] << 16);
          w1.x = (vw[0] >> 16) | (vw[1] & 0xffff0000u); w1.y = (vw[2] >> 16) | (vw[3] & 0xffff0000u); w1.z = (vw[4] >> 16) | (vw[5] & 0xffff0000u); w1.w = (vw[6] >> 16) | (vw[7] & 0xffff0000u);
          *(LAS u32x4*)(lds + HG_VT + (2 * lane) * 144 + 16 * wave) = w0; *(LAS u32x4*)(lds + HG_VT + (2 * lane + 1) * 144 + 16 * wave) = w1; }
        float ngv[4]; unsigned short gzv[4][4];
#pragma unroll
        for (int n = 0; n < 4; ++n) ngv[n] = ng[h * 128 + 64 * nh + 16 * n + fr];
#pragma unroll
        for (int r = 0; r < 4; ++r)
#pragma unroll
            for (int n = 0; n < 4; ++n) gzv[r][n] = Z[(rowc + 16 * ti + 4 * q + r) * NIN + 1536 + h * 128 + 64 * nh + 16 * n + fr];
        lds_barrier();
        xcvt_store_h(a, xid, 0, lane, cv); xcvt_load_h(a, xid, 1, lane, cv);
        f32x4 acc[4];
#pragma unroll
        for (int n = 0; n < 4; ++n) acc[n] = (f32x4){0.f, 0.f, 0.f, 0.f};
#pragma unroll
        for (int ks = 0; ks < 4; ++ks) { const bf16x8 qa = *(const LAS bf16x8*)(lds + HG_QT + (16 * ti + fr) * 272 + ks * 64 + q * 16);
#pragma unroll
            for (int n = 0; n < 4; ++n) acc[n] = __builtin_amdgcn_mfma_f32_16x16x32_bf16(qa, sf[n][ks], acc[n], 0, 0, 0); }
        bf16x8 qh[4];
#pragma unroll
        for (int ks = 0; ks < 4; ++ks) qh[ks] = *(const LAS bf16x8*)(lds + HG_QH + (16 * ti + fr) * 272 + ks * 64 + q * 16);
        unsigned P[4][2];
#pragma unroll
        for (int j = 0; j < 4; ++j) { P[j][0] = 0u; P[j][1] = 0u;
            if (j <= ti) { f32x4 st = (f32x4){0.f, 0.f, 0.f, 0.f};
#pragma unroll
                for (int ks = 0; ks < 4; ++ks) { const bf16x8 kf = *(const LAS bf16x8*)(lds + HG_KH + (8 * ti * (ti + 1) + 16 * j + fr) * 272 + ks * 64 + q * 16); st = __builtin_amdgcn_mfma_f32_16x16x32_bf16(kf, qh[ks], st, 0, 0, 0); }
                if (j == ti) {
#pragma unroll
                    for (int r = 0; r < 4; ++r) st[r] = (4 * q + r <= fr) ? st[r] : 0.f; }
                P[j][0] = pk2(st[0], st[1]); P[j][1] = pk2(st[2], st[3]); } }
#pragma unroll
        for (int jp = 0; jp < 2; ++jp) { if (2 * jp <= ti) { const bf16x8 pa = mk_frag(P[2 * jp][0], P[2 * jp][1], P[2 * jp + 1][0], P[2 * jp + 1][1]);
#pragma unroll
            for (int n = 0; n < 4; ++n) { const int vv = 64 * nh + 16 * n + fr;
                const u32x2 lo = *(const LAS u32x2*)(lds + HG_VT + vv * 144 + (32 * jp + 4 * q) * 2), hi = *(const LAS u32x2*)(lds + HG_VT + vv * 144 + (32 * jp + 16 + 4 * q) * 2);
                acc[n] = __builtin_amdgcn_mfma_f32_16x16x32_bf16(pa, mk_frag(lo.x, lo.y, hi.x, hi.y), acc[n], 0, 0, 0); } } }
        LAS float* SS = (LAS float*)(lds + HG_SS);
        float ssq[4];
#pragma unroll
        for (int r = 0; r < 4; ++r) { float sq = 0.f;
#pragma unroll
            for (int n = 0; n < 4; ++n) sq += acc[n][r] * acc[n][r];
            ssq[r] = row16_sum(sq); }
        if (fr == 0) {
#pragma unroll
            for (int r = 0; r < 4; ++r) SS[(16 * ti + 4 * q + r) * 2 + nh] = ssq[r]; }
        lds_barrier();
#pragma unroll
        for (int r = 0; r < 4; ++r) { const int t = 16 * ti + 4 * q + r; const float rstd = rsqrtf((SS[t * 2] + SS[t * 2 + 1]) * (1.0f / 128.0f) + EPS);
#pragma unroll
            for (int n = 0; n < 4; ++n) { const int col = h * 128 + 64 * nh + 16 * n + fr; const float val = acc[n][r] * rstd * ngv[n] * bf2f(gzv[r][n]), oth = lane_xor1(val);
                if ((fr & 1) == 0) *(unsigned*)(YMIX + (rowc + t) * DM + col) = pk2(val, oth); } }
        xcvt_store_h(a, xid, 1, lane, cv);
        lds_barrier();
    }
}

constexpr int GM_WS = 0, GM_VT = 34816;
__device__ __forceinline__ void gmlp_unit(const Args& a, LAS unsigned char* lds, int unit, int tid, int wave, int lane, int xid) {
    const int g = unit & 3, bn = unit >> 2, fr = lane & 15, q = lane >> 4; const size_t r0 = (size_t)bn * 128;
    const bf16* Z = (const bf16*)(a.ws + WS_Z); bf16* YMIX = (bf16*)(a.ws + WS_YMIX);
    { const u32x4* wsb = (const u32x4*)(a.ws + WS_GWS + (size_t)g * 32768);
      u32x4 wv[4];
#pragma unroll
      for (int it = 0; it < 4; ++it) wv[it] = wsb[tid + 512 * it];
#pragma unroll
      for (int it = 0; it < 4; ++it) { const int idx = tid + 512 * it; *(LAS u32x4*)(lds + GM_WS + (idx >> 4) * 272 + (idx & 15) * 16) = wv[it]; } }
    u32x4 xc[16];
    { const u32x4* zr = (const u32x4*)(Z + (r0 + 16 * wave + fr) * NIN + 2560) + q;
#pragma unroll
      for (int j = 0; j < 16; ++j) xc[j] = zr[4 * j]; }
    { float sm = 0.f, sq = 0.f;
#pragma unroll
      for (int j = 0; j < 16; ++j) { const float e[8] = {bflo(xc[j].x), bfhi(xc[j].x), bflo(xc[j].y), bfhi(xc[j].y), bflo(xc[j].z), bfhi(xc[j].z), bflo(xc[j].w), bfhi(xc[j].w)};
#pragma unroll
          for (int t = 0; t < 8; ++t) { sm += e[t]; sq += e[t] * e[t]; } }
      sm += __shfl_xor(sm, 16); sm += __shfl_xor(sm, 32); sq += __shfl_xor(sq, 16); sq += __shfl_xor(sq, 32);
      const float mu = sm * (1.0f / 512.0f), rstd = rsqrtf(fmaxf(sq * (1.0f / 512.0f) - mu * mu, 0.f) + EPS);
      const int row = 16 * wave + fr;
#pragma unroll
      for (int jj = 0; jj < 4; ++jj) { const u32x4 x = (g == 0) ? xc[jj] : (g == 1) ? xc[4 + jj] : (g == 2) ? xc[8 + jj] : xc[12 + jj];
          const float e[8] = {bflo(x.x), bfhi(x.x), bflo(x.y), bfhi(x.y), bflo(x.z), bfhi(x.z), bflo(x.w), bfhi(x.w)}; const int d0 = 8 * (q + 4 * jj);
          const f32x4 lg0 = *(const f32x4*)(a.in[I_LNG] + g * 128 + d0), lg1 = *(const f32x4*)(a.in[I_LNG] + g * 128 + d0 + 4), lb0 = *(const f32x4*)(a.in[I_LNB] + g * 128 + d0), lb1 = *(const f32x4*)(a.in[I_LNB] + g * 128 + d0 + 4);
          const float lgv[8] = {lg0.x, lg0.y, lg0.z, lg0.w, lg1.x, lg1.y, lg1.z, lg1.w}, lbv[8] = {lb0.x, lb0.y, lb0.z, lb0.w, lb1.x, lb1.y, lb1.z, lb1.w};
#pragma unroll
          for (int t = 0; t < 8; ++t) { const float val = (e[t] - mu) * rstd * lgv[t] + lbv[t];
              *(LAS unsigned short*)(lds + GM_VT + (d0 + t) * 272 + row * 2) = (unsigned short)(pk2(val, 0.f) & 0xffffu); } } }
    float gnv[8], bsv4[4]; unsigned short uzv[4][8];
#pragma unroll
    for (int n = 0; n < 8; ++n) gnv[n] = a.in[I_GNG][g * 128 + 16 * n + fr];
#pragma unroll
    for (int r = 0; r < 4; ++r) { bsv4[r] = a.in[I_GBS][g * 128 + 16 * wave + 4 * q + r];
#pragma unroll
        for (int n = 0; n < 8; ++n) uzv[r][n] = Z[(r0 + 16 * wave + 4 * q + r) * NIN + 2048 + g * 128 + 16 * n + fr]; }
    lds_barrier();
    f32x4 acc[8];
#pragma unroll
    for (int n = 0; n < 8; ++n) acc[n] = (f32x4){0.f, 0.f, 0.f, 0.f};
    const int nks = (wave + 2) >> 1;
#pragma unroll
    for (int ks = 0; ks < 4; ++ks) { if (ks < nks) { const bf16x8 af = *(const LAS bf16x8*)(lds + GM_WS + (16 * wave + fr) * 272 + ks * 64 + q * 16);
#pragma unroll
        for (int n = 0; n < 8; ++n) { const bf16x8 bfr = *(const LAS bf16x8*)(lds + GM_VT + (16 * n + fr) * 272 + ks * 64 + q * 16); acc[n] = __builtin_amdgcn_mfma_f32_16x16x32_bf16(af, bfr, acc[n], 0, 0, 0); } } }
#pragma unroll
    for (int r = 0; r < 4; ++r) { const int t = 16 * wave + 4 * q + r; const float bsv = bsv4[r]; float y[8]; float s = 0.f;
#pragma unroll
        for (int n = 0; n < 8; ++n) { const float u = bf2f(uzv[r][n]); y[n] = u * (acc[n][r] + bsv); s += y[n] * y[n]; }
        s = row16_sum(s);
        const float rstd = rsqrtf(s * (1.0f / 128.0f) + EPS);
#pragma unroll
        for (int n = 0; n < 8; ++n) { const int d = 16 * n + fr; const float val = y[n] * rstd * gnv[n], oth = lane_xor1(val);
            if ((fr & 1) == 0) *(unsigned*)(YMIX + (r0 + t) * DM + 512 + g * 128 + d) = pk2(val, oth); } }
    lds_barrier();
}

__device__ __forceinline__ void moe_table(const Args& a, volatile LAS unsigned* MISC, int wave, int lane) {
    if (wave == 0) {
        unsigned* cntg = (unsigned*)(a.ws + WS_CTL) + CW_CNT;
        const int c = lane < 32 ? (int)__hip_atomic_load(cntg + CNT_STRIDE * lane, __ATOMIC_RELAXED, __HIP_MEMORY_SCOPE_AGENT) : 0;
        const int nb = (c + 255) >> 8; int incl = nb;
#pragma unroll
        for (int o = 1; o < 32; o <<= 1) { const int t = __shfl_up(incl, o); if (lane >= o) incl += t; }
        if (lane < 32) { MISC[MOE_TAB + lane] = (unsigned)c; MISC[MOE_TAB + 32 + lane] = (unsigned)(incl - nb); }
        if (lane == 31) MISC[MOE_TAB + 64] = (unsigned)incl;
    }
    __syncthreads();
}

__device__ __forceinline__ void p9_final(const Args& a, LAS unsigned char* lds, int vcu, int G, int tid, int wave, int lane) {
    const int gw = vcu * 8 + wave, NGW = G * 8, c0 = 16 * lane;
    const float* mod = (const float*)(a.ws + WS_MOD);
    const bf16* xmid = (const bf16*)(a.ws + WS_XMID);
    const unsigned char* ys = (const unsigned char*)(a.ws + WS_YSLOT);
    LAS float* G2 = (LAS float*)lds;
    { float t8[8];
#pragma unroll
      for (int it = 0; it < 8; ++it) { const int i = tid + 512 * it; t8[it] = mod[(i >> 10) * 6144 + 5120 + (i & 1023)]; }
#pragma unroll
      for (int it = 0; it < 8; ++it) G2[tid + 512 * it] = t8[it]; }
    f32x4 fg[4];
#pragma unroll
    for (int j = 0; j < 4; ++j) fg[j] = *(const f32x4*)(a.in[I_FG] + c0 + 4 * j);
    lds_barrier();
    for (int m0 = gw; m0 < MT; m0 += 4 * NGW) {
        u32x4 yw[4][4]; u32x4 xw[4][2];
#pragma unroll
        for (int r = 0; r < 4; ++r) { const int mm = m0 + r * NGW, m = mm < MT ? mm : m0;
#pragma unroll
            for (int k = 0; k < 4; ++k) yw[r][k] = *(const u32x4*)(ys + ((size_t)m * 4 + k) * DM + c0);
            xw[r][0] = *(const u32x4*)(xmid + (size_t)m * DM + c0); xw[r][1] = *(const u32x4*)(xmid + (size_t)m * DM + c0 + 8); }
#pragma unroll
        for (int r = 0; r < 4; ++r) { const int m = m0 + r * NGW, b = (m < MT ? m : m0) / SEQ;
            float y[16];
#pragma unroll
            for (int i = 0; i < 16; ++i) y[i] = 0.f;
#pragma unroll
            for (int k = 0; k < 4; ++k)
#pragma unroll
                for (int d = 0; d < 4; ++d) { const int w = (int)yw[r][k][d]; const f32x2 lo = __builtin_amdgcn_cvt_pk_f32_fp8(w, false), hi = __builtin_amdgcn_cvt_pk_f32_fp8(w, true);
                    y[4 * d] += lo.x; y[4 * d + 1] += lo.y; y[4 * d + 2] += hi.x; y[4 * d + 3] += hi.y; }
            float v[16]; float ss = 0.f;
#pragma unroll
            for (int j = 0; j < 4; ++j) { const f32x4 g2 = *(const LAS f32x4*)(G2 + b * 1024 + c0 + 4 * j);
#pragma unroll
                for (int t = 0; t < 4; ++t) { const int i = 4 * j + t; const unsigned w = xw[r][i >> 3][(i >> 1) & 3]; const float xv = (i & 1) ? bfhi(w) : bflo(w);
                    v[i] = xv + g2[t] * (y[i] * (1.0f / YS_SCALE)); ss += v[i] * v[i]; } }
            const float rstd = rsqrtf(wave_sum(ss) * (1.0f / DM) + EPS);
            if (m < MT) { f32x4* orow = (f32x4*)(a.out + (size_t)m * DM + c0);
#pragma unroll
                for (int j = 0; j < 4; ++j) orow[j] = (f32x4){v[4 * j] * rstd * fg[j].x, v[4 * j + 1] * rstd * fg[j].y, v[4 * j + 2] * rstd * fg[j].z, v[4 * j + 3] * rstd * fg[j].w}; } }
    }
}

constexpr int NPH = 12;
__global__ void __launch_bounds__(512, 2) mk_fwd(Args a) {
    extern __shared__ __attribute__((aligned(16))) unsigned char lds_raw[];
    LAS unsigned char* lds = (LAS unsigned char*)lds_raw;
    volatile LAS unsigned* MISC = (volatile LAS unsigned*)(lds + LDSCTL_OFF);
    const int tid = threadIdx.x, lane = tid & 63, wave = __builtin_amdgcn_readfirstlane(tid >> 6);
    const int G = gridDim.x; const int bx = blockIdx.x; const int vcu = (G % 8 == 0) ? (bx % 8) * (G / 8) + bx / 8 : bx;
    for (int u = tid; u < (LDS_BYTES - LDSCTL_OFF) / 4; u += 512) MISC[u] = 0u;
    __syncthreads();
    unsigned* ctl = (unsigned*)(a.ws + WS_CTL);
    const int lo = a.ph_lo, hi = a.ph_hi;
    const bool multi = (hi - lo) > 1;
    XcdBarrier bar; bar.bar = ctl + CW_BAR; bar.x = 0; bar.st = nullptr;
    if (multi) bar = xcd_barrier_post(ctl + CW_BAR, MISC + MISC_BAR);
#ifndef PH_MASK
#define PH_MASK 0xFFFF
#endif
#define IN(k) (((PH_MASK >> (k)) & 1) && lo <= (k) && (k) < hi)
#define SEAM(k) do { if (IN(k) && IN((k) + 1)) xcd_barrier(bar); } while (0)
    unsigned char* ws = a.ws;

#ifndef REP_MASK
#define REP_MASK 0
#endif
#ifndef AMP_MASK
#define AMP_MASK 0
#endif
#define PHASE(k, ...) do { if (IN(k)) { const unsigned long long _t0 = ((AMP_MASK >> (k)) & 1) ? __builtin_amdgcn_s_memrealtime() : 0ull; \
        for (int _r = 0; _r <= ((REP_MASK >> (k)) & 1); ++_r) { if (_r) xcd_barrier(bar); __VA_ARGS__ } \
        if ((AMP_MASK >> (k)) & 1) { asm volatile("s_waitcnt vmcnt(0)" ::: "memory"); __syncthreads(); const unsigned long long _t1 = __builtin_amdgcn_s_memrealtime(); while (__builtin_amdgcn_s_memrealtime() - _t1 < 3ull * (_t1 - _t0)) __builtin_amdgcn_s_sleep(8); } } SEAM(k); } while (0)
    PHASE(0, { p0_prologue(a, lds, vcu, G, tid, wave, lane); p1_h1(a, lds, vcu, G, tid, wave, lane); });
    PHASE(2, {
        pg8::DenseSchedT<true> S; S.init((const bf16*)(ws + WS_H), (const bf16*)(ws + WS_WIN), MT, NIN, DM / 2, G, bx);
        EpiZ E{(bf16*)(ws + WS_Z), (const float*)(ws + WS_LB), (const float*)(ws + WS_SA), (const float*)(ws + WS_SB)};
        pg8::gemm_phase<EpiZ, pg8::DenseSchedT<true>>(lds, S, E); });
    PHASE(3, {
        hgrnA_phase(a, lds, bx, G, wave, lane);
        for (int it = 1024 + bx; it < 1536; it += G) gmlp_unit(a, lds, it - 1024, tid, wave, lane, XI_P3 + it * 8 + wave); });
    PHASE(4, hgrnB_scan((bf16*)(ws + WS_KV), (bf16*)(ws + (_r ? WS_OH : WS_KV)), (const float*)(ws + WS_DEC), bx * 512 + tid, G * 512););
    PHASE(5, hgrnC_phase(a, lds, bx, G, wave, lane););
    PHASE(6, {
        pg8::DenseSched S; S.init((const bf16*)(ws + WS_YMIX), (const bf16*)(ws + WS_WOUT), MT, DM, DM, G, bx);
        EpiXmid E{a.in[I_XIN], (bf16*)(ws + WS_XMID), (const float*)(ws + WS_MOD)};
        pg8::gemm_phase<EpiXmid, pg8::DenseSched>(lds, S, E); });
    PHASE(7, {
        int role, ridx, NR, NC;
        if (G == 256) {
            const int gidx = bx >> 3; role = (gidx % 3 == 2 || gidx == 31) ? 1 : 0; NR = 88; NC = 168;
            ridx = role ? ((gidx == 31 ? 10 : gidx / 3) * 8 + (bx & 7)) : ((gidx - (gidx + 1) / 3) * 8 + (bx & 7));
        } else { const bool x32 = (G % 32) == 0; const int sub = x32 ? (bx >> 3) & 3 : bx & 3; role = sub == 3 ? 1 : 0; NR = G / 4; NC = G - NR;
            ridx = role ? (x32 ? (bx >> 5) * 8 + (bx & 7) : bx >> 2) : (x32 ? (bx >> 5) * 24 + sub * 8 + (bx & 7) : (bx >> 2) * 3 + sub); }
        if (role == 0) { const int gw7 = ridx * 8 + wave, NGW7 = NC * 8; f32x4 ca[16], cb[16];
          if (gw7 < 16384) xcvt_load(a, gw7, lane, ca);
          for (int it = gw7; it < 16384; it += 2 * NGW7) {
              if (it + NGW7 < 16384) xcvt_load(a, it + NGW7, lane, cb);
              xcvt_store(a, it, lane, ca);
              if (it + 2 * NGW7 < 16384) xcvt_load(a, it + 2 * NGW7, lane, ca);
              if (it + NGW7 < 16384) xcvt_store(a, it + NGW7, lane, cb); } }
        else p6_router(a, lds, ridx, NR, tid, wave, lane, _r != 0); });
    PHASE(8, {
        moe_table(a, MISC, wave, lane);
        const int RB = (int)MISC[MOE_TAB + 64], U8 = RB * 8, U8a = (U8 / G) * G;
        pg8::MoeSched<true> S; S.A = (const bf16*)(ws + WS_H); S.W = (const bf16*)(ws + WS_WGU); S.K = DM / 2; S.NT = 8; S.lists = (const int*)(ws + WS_LISTS);
        S.tab = (const LAS int*)(MISC + MOE_TAB); S.G = G; S.c = bx; S.lo = 0; S.U = U8a;
        EpiAct E{(bf16*)(ws + WS_ACT), a.in[I_BGU]};
        pg8::gemm_phase<EpiAct, pg8::MoeSched<true>>(lds, S, E); });
    PHASE(9, {
        moe_table(a, MISC, wave, lane);
        const int RB = (int)MISC[MOE_TAB + 64], U8 = RB * 8, U8a = (U8 / G) * G, T8 = U8 - U8a, U9 = RB * 4, D9 = (G - T8) < U9 ? (G - T8) : U9;
        if (bx < T8) {
            pg8::MoeSched<true> S; S.A = (const bf16*)(ws + WS_H); S.W = (const bf16*)(ws + WS_WGU); S.K = DM / 2; S.NT = 8; S.lists = (const int*)(ws + WS_LISTS);
            S.tab = (const LAS int*)(MISC + MOE_TAB); S.G = G; S.c = bx; S.lo = U8a; S.U = T8;
            EpiAct E{(bf16*)(ws + WS_ACT), a.in[I_BGU]};
            pg8::gemm_phase<EpiAct, pg8::MoeSched<true>>(lds, S, E);
        } else {
            pg8::MoeSched<false> S; S.A = (const bf16*)(ws + WS_ACT); S.W = (const bf16*)(ws + WS_WD); S.K = DFF / 2; S.NT = 4; S.lists = (const int*)(ws + WS_LISTS);
            S.tab = (const LAS int*)(MISC + MOE_TAB); S.G = G; S.c = bx - T8; S.lo = 0; S.U = D9;
            EpiDown E{(unsigned char*)(ws + WS_YSLOT), a.in[I_BD], (const float*)(ws + WS_LGATE), (const int*)(ws + WS_LISTS)};
            pg8::gemm_phase<EpiDown, pg8::MoeSched<false>>(lds, S, E);
        } });
    PHASE(10, {
        moe_table(a, MISC, wave, lane);
        const int RB = (int)MISC[MOE_TAB + 64], U8 = RB * 8, T8 = U8 - (U8 / G) * G, U9 = RB * 4, D9 = (G - T8) < U9 ? (G - T8) : U9;
        pg8::MoeSched<false> S; S.A = (const bf16*)(ws + WS_ACT); S.W = (const bf16*)(ws + WS_WD); S.K = DFF / 2; S.NT = 4; S.lists = (const int*)(ws + WS_LISTS);
        S.tab = (const LAS int*)(MISC + MOE_TAB); S.G = G; S.c = bx; S.lo = D9; S.U = U9 - D9;
        EpiDown E{(unsigned char*)(ws + WS_YSLOT), a.in[I_BD], (const float*)(ws + WS_LGATE), (const int*)(ws + WS_LISTS)};
        pg8::gemm_phase<EpiDown, pg8::MoeSched<false>>(lds, S, E); });
    PHASE(11, p9_final(a, lds, vcu, G, tid, wave, lane););
#undef PHASE
#undef IN
#undef SEAM
}

extern "C" void kernel_launch(void* const* d_in, const int* in_sizes, int n_in, void* d_out, int out_size, void* d_ws, size_t ws_size, hipStream_t stream) {
    static int grid = 0;
    if (grid == 0) {
        if (n_in != 22 || in_sizes[0] != MT * DM || out_size != MT * DM || ws_size < WS_END) { fprintf(stderr, "kernel_launch: unexpected shapes (n_in %d, in0 %d, out %d, ws %zu)\n", n_in, n_in > 0 ? in_sizes[0] : -1, out_size, ws_size); grid = -1; return; }
        int dev = 0, cus = 0, per_cu = 0;
        if (hipGetDevice(&dev) != hipSuccess || hipDeviceGetAttribute(&cus, hipDeviceAttributeMultiprocessorCount, dev) != hipSuccess) { grid = -1; return; }
        if (hipFuncSetAttribute((const void*)mk_fwd, hipFuncAttributeMaxDynamicSharedMemorySize, LDS_BYTES) != hipSuccess) { fprintf(stderr, "kernel_launch: hipFuncSetAttribute failed\n"); grid = -1; return; }
        if (hipOccupancyMaxActiveBlocksPerMultiprocessor(&per_cu, (const void*)mk_fwd, 512, LDS_BYTES) != hipSuccess || per_cu < 1) fprintf(stderr, "kernel_launch: occupancy query says %d\n", per_cu);
        (void)hipGetLastError();
        grid = cus;
    }
    if (grid < 0) return;
    (void)hipMemsetAsync((char*)d_ws + WS_CTL, 0, CTL_ZERO_BYTES, stream);
    Args a{};
    for (int i = 0; i < 22; ++i) a.in[i] = (const float*)d_in[i];
    a.out = (float*)d_out; a.ws = (unsigned char*)d_ws;
    auto run = [&](int lo, int hi) { a.ph_lo = lo; a.ph_hi = hi; hipLaunchKernelGGL(mk_fwd, dim3(grid), dim3(512), LDS_BYTES, stream, a); };
    run(0, NPH);
}
```
